# Optimizing an MI355X kernel written in HIP

```python
import math
import jax, jax.numpy as jnp
from jax import lax
import numpy as np

D_MODEL = 1024
BATCH = 4
SEQ = 8192
DEPTH = 4

PLE_DIM = 256
D_FF = 2816
D_RNN = D_MODEL
RNN_BLOCKS = 16
RNN_BW = D_RNN // RNN_BLOCKS
CONV_W = 4
RG_C = 8.0
N_HEADS = 8
HEAD_DIM = 128
D_ATTN = N_HEADS * HEAD_DIM
Q_BLOCK = 128
N_IN = 2 * D_RNN + 3 * D_ATTN + N_HEADS + 2 * D_MODEL
EPS = 1e-6

kernel_name = "hybrid_rglru_fox_macaron_ple"


def rms_norm(x, g):
    xf = x.astype(jnp.float32)
    y = xf * lax.rsqrt(jnp.mean(xf * xf, axis=-1, keepdims=True) + EPS)
    return (y * g.astype(jnp.float32)).astype(x.dtype)


def swiglu_ffn(h, w_in, w_out):
    g, u = jnp.split(h @ w_in, 2, axis=-1)
    return (jax.nn.silu(g) * u) @ w_out


def causal_dwconv(x, w, b):
    S = x.shape[1]
    xp = jnp.pad(x, ((0, 0), (CONV_W - 1, 0), (0, 0)))
    y = b + xp[:, 0:S] * w[0]
    for k in range(1, CONV_W):
        y = y + xp[:, k:k + S] * w[k]
    return y


def rg_lru(x, w_a, b_a, w_x, b_x, lam):
    B, S, C = x.shape
    xb = x.reshape(B, S, RNN_BLOCKS, RNN_BW)
    r = jax.nn.sigmoid(jnp.einsum('bsnc,ncd->bsnd', xb, w_a).reshape(B, S, C) + b_a)
    i = jax.nn.sigmoid(jnp.einsum('bsnc,ncd->bsnd', xb, w_x).reshape(B, S, C) + b_x)
    log_a = -RG_C * r.astype(jnp.float32) * jax.nn.softplus(-lam.astype(jnp.float32))
    a = jnp.exp(log_a)
    mult = jnp.sqrt(-jnp.expm1(2.0 * log_a))
    u = mult * (i * x).astype(jnp.float32)

    def combine(left, right):
        a1, b1 = left
        a2, b2 = right
        return a1 * a2, a2 * b1 + b2

    _, h = lax.associative_scan(combine, (a, u), axis=1)
    return h.astype(x.dtype)


def forgetting_attention(q, k, v, f_logit, f_b, q_g, k_g):
    B, S, _ = q.shape
    q = rms_norm(q.reshape(B, S, N_HEADS, HEAD_DIM), q_g)
    k = rms_norm(k.reshape(B, S, N_HEADS, HEAD_DIM), k_g)
    v = v.reshape(B, S, N_HEADS, HEAD_DIM)
    log_f = jax.nn.log_sigmoid((f_logit + f_b).astype(jnp.float32))
    dcum = jnp.cumsum(log_f, axis=1).transpose(0, 2, 1)
    qh = q.transpose(0, 2, 1, 3)
    kh = k.transpose(0, 2, 1, 3)
    vh = v.transpose(0, 2, 1, 3)
    nb = S // Q_BLOCK
    q_blocks = qh.reshape(B, N_HEADS, nb, Q_BLOCK, HEAD_DIM).transpose(2, 0, 1, 3, 4)
    d_blocks = dcum.reshape(B, N_HEADS, nb, Q_BLOCK).transpose(2, 0, 1, 3)
    kpos = jnp.arange(S)
    scale = 1.0 / math.sqrt(HEAD_DIM)

    def one_block(args):
        qb, dqb, blk = args
        s = jnp.einsum('bhqd,bhkd->bhqk', qb, kh).astype(jnp.float32) * scale
        s = s + dqb[..., None] - dcum[:, :, None, :]
        qpos = blk * Q_BLOCK + jnp.arange(Q_BLOCK)
        s = jnp.where(kpos[None, :] <= qpos[:, None], s, -jnp.inf)
        pr = jax.nn.softmax(s, axis=-1).astype(vh.dtype)
        return jnp.einsum('bhqk,bhkd->bhqd', pr, vh)

    o = lax.map(one_block, (q_blocks, d_blocks, jnp.arange(nb)))
    return o.transpose(1, 0, 3, 2, 4).reshape(B, S, D_ATTN)


def setup_inputs(seed: int = 0) -> dict:
    key = jax.random.key(seed)
    ks = jax.random.split(key, 32)
    f32 = jnp.float32

    def nrm(k, shape, fan_in):
        return jax.random.normal(k, shape, f32) * (fan_in ** -0.5)

    def gain(k, shape):
        return 1.0 + 0.05 * jax.random.normal(k, shape, f32)

    def small(k, shape):
        return 0.02 * jax.random.normal(k, shape, f32)

    a_c = jax.random.uniform(ks[12], (DEPTH, D_RNN), f32, 0.9, 0.999)
    s = a_c ** (1.0 / RG_C)
    rg_lambda = jnp.log(s) - jnp.log1p(-s)

    return {
        "x": jax.random.normal(ks[0], (BATCH, SEQ, D_MODEL), f32),
        "p": jax.random.normal(ks[1], (DEPTH, BATCH, SEQ, PLE_DIM), f32),
        "ffn1_norm": gain(ks[2], (DEPTH, D_MODEL)),
        "ffn1_w_in": nrm(ks[3], (DEPTH, D_MODEL, 2 * D_FF), D_MODEL),
        "ffn1_w_out": nrm(ks[4], (DEPTH, D_FF, D_MODEL), D_FF),
        "mix_norm": gain(ks[5], (DEPTH, D_MODEL)),
        "w_in": nrm(ks[6], (DEPTH, D_MODEL, N_IN), D_MODEL),
        "merge_b": small(ks[7], (DEPTH, 2 * D_MODEL)),
        "conv_w": nrm(ks[8], (DEPTH, CONV_W, D_RNN), CONV_W),
        "conv_b": small(ks[9], (DEPTH, D_RNN)),
        "rg_wa": nrm(ks[10], (DEPTH, RNN_BLOCKS, RNN_BW, RNN_BW), RNN_BW),
        "rg_ba": small(ks[11], (DEPTH, D_RNN)),
        "rg_wx": nrm(ks[13], (DEPTH, RNN_BLOCKS, RNN_BW, RNN_BW), RNN_BW),
        "rg_bx": small(ks[14], (DEPTH, D_RNN)),
        "rg_lambda": rg_lambda,
        "f_b": jax.random.uniform(ks[15], (DEPTH, N_HEADS), f32, 1.0, 4.0),
        "q_norm": gain(ks[16], (DEPTH, HEAD_DIM)),
        "k_norm": gain(ks[17], (DEPTH, HEAD_DIM)),
        "w_rnn_out": nrm(ks[18], (DEPTH, D_RNN, D_MODEL), D_RNN),
        "w_attn_out": nrm(ks[19], (DEPTH, D_ATTN, D_MODEL), D_ATTN),
        "w_o": nrm(ks[20], (DEPTH, D_MODEL, D_MODEL), D_MODEL),
        "ffn2_norm": gain(ks[21], (DEPTH, D_MODEL)),
        "ffn2_w_in": nrm(ks[22], (DEPTH, D_MODEL, 2 * D_FF), D_MODEL),
        "ffn2_w_out": nrm(ks[23], (DEPTH, D_FF, D_MODEL), D_FF),
        "ple_norm": gain(ks[24], (DEPTH, D_MODEL)),
        "ple_w_gate": nrm(ks[25], (DEPTH, D_MODEL, D_MODEL), D_MODEL),
        "ple_b_gate": small(ks[26], (DEPTH, D_MODEL)),
        "ple_w_proj": nrm(ks[27], (DEPTH, PLE_DIM, D_MODEL), PLE_DIM),
        "final_norm": gain(ks[28], (D_MODEL,)),
    }


def reference(x, p, ffn1_norm, ffn1_w_in, ffn1_w_out, mix_norm, w_in, merge_b,
              conv_w, conv_b, rg_wa, rg_ba, rg_wx, rg_bx, rg_lambda, f_b, q_norm, k_norm,
              w_rnn_out, w_attn_out, w_o, ffn2_norm, ffn2_w_in, ffn2_w_out,
              ple_norm, ple_w_gate, ple_b_gate, ple_w_proj, final_norm):
    split_idx = list(np.cumsum([D_RNN, D_RNN, D_ATTN, D_ATTN, D_ATTN, N_HEADS, D_MODEL]))
    for i in range(DEPTH):
        x = x + 0.5 * swiglu_ffn(rms_norm(x, ffn1_norm[i]), ffn1_w_in[i], ffn1_w_out[i])

        h = rms_norm(x, mix_norm[i])
        proj = h @ w_in[i]
        rx, rgate, q, k, v, f_logit, ga, gb = jnp.split(proj, split_idx, axis=-1)

        rx = causal_dwconv(rx, conv_w[i], conv_b[i])
        ya = rg_lru(rx, rg_wa[i], rg_ba[i], rg_wx[i], rg_bx[i], rg_lambda[i])
        ya = (ya * jax.nn.gelu(rgate)) @ w_rnn_out[i]

        yb = forgetting_attention(q, k, v, f_logit, f_b[i], q_norm[i], k_norm[i]) @ w_attn_out[i]

        mb_a, mb_b = jnp.split(merge_b[i], 2)
        merged = jax.nn.sigmoid(ga + mb_a) * ya + jax.nn.sigmoid(gb + mb_b) * yb
        x = x + merged @ w_o[i]

        x = x + 0.5 * swiglu_ffn(rms_norm(x, ffn2_norm[i]), ffn2_w_in[i], ffn2_w_out[i])

        gate = jax.nn.sigmoid(rms_norm(x, ple_norm[i]) @ ple_w_gate[i] + ple_b_gate[i])
        x = x + gate * (p[i] @ ple_w_proj[i])
    return rms_norm(x, final_norm)
```

```cpp
#include <hip/hip_runtime.h>
#include <hip/hip_cooperative_groups.h>
#include <hip/hip_bf16.h>
#include <cstdio>
#include <cstdint>
namespace cg = cooperative_groups;

#ifndef PROBE
#define PROBE 0
#endif
#define LAS __attribute__((address_space(3)))
typedef unsigned short bf16_t;
typedef short bf16x8 __attribute__((ext_vector_type(8)));
typedef short s16x4 __attribute__((ext_vector_type(4)));
typedef float f32x4 __attribute__((ext_vector_type(4)));
typedef float f32x16 __attribute__((ext_vector_type(16)));
typedef unsigned u32x4 __attribute__((ext_vector_type(4)));
typedef unsigned u32x2 __attribute__((ext_vector_type(2)));

constexpr int NB = 4, SEQ = 8192, T = NB * SEQ, DM = 1024, FF = 2816, NH = 8, HD = 128, NL = 4, PLE = 256, NIN = 7176;
constexpr float EPS = 1e-6f;
constexpr float LOG2E = 1.4426950408889634f;

constexpr size_t MiB = 1u << 20;
constexpr size_t WS_SS0 = 0, WS_SS1 = 2 * MiB, WS_LOGF = 4 * MiB, WS_ND2 = 5 * MiB, WS_AGG = 6 * MiB, WS_VEC = 8 * MiB;
constexpr size_t WS_W1IN = 16 * MiB, WS_W1OUT = 27 * MiB, WS_WIN = 33 * MiB, WS_WG = 47 * MiB, WS_WR = 48 * MiB, WS_WAT = 50 * MiB, WS_WO = 52 * MiB,
                 WS_W2IN = 54 * MiB, WS_W2OUT = 65 * MiB, WS_WPG = 71 * MiB, WS_WPE = 73 * MiB;
constexpr size_t WS_XB = 80 * MiB, WS_PB = 144 * MiB, WS_R = 160 * MiB, WS_X1 = 608 * MiB, WS_END = 672 * MiB;
constexpr size_t BUF = 64 * MiB;
constexpr int LDS_BYTES = 147456;

__device__ __forceinline__ unsigned cvtpk(float lo, float hi) { unsigned r; asm volatile("v_cvt_pk_bf16_f32 %0, %1, %2" : "=v"(r) : "v"(lo), "v"(hi)); return r; }
__device__ __forceinline__ float bflo(unsigned u) { return __uint_as_float(u << 16); }
__device__ __forceinline__ float bfhi(unsigned u) { return __uint_as_float(u & 0xffff0000u); }
__device__ __forceinline__ float sigmoidf_(float x) { return __builtin_amdgcn_rcpf(1.f + __builtin_amdgcn_exp2f(-x * LOG2E)); }
__device__ __forceinline__ float gelu_tanh(float x) { const float u2 = 1.5957691216f * (x + 0.044715f * x * x * x); return x * sigmoidf_(u2); }
__device__ __forceinline__ float row_rstd(const float* ss, int row) {
    const f32x4* p = (const f32x4*)(ss + (size_t)row * 16);
    const f32x4 a = p[0], b = p[1], c = p[2], d = p[3];
    const float s = ((a[0] + a[1]) + (a[2] + a[3])) + ((b[0] + b[1]) + (b[2] + b[3])) + ((c[0] + c[1]) + (c[2] + c[3])) + ((d[0] + d[1]) + (d[2] + d[3]));
    return rsqrtf(s * (1.f / 1024.f) + EPS);
}
#define LDS_WAIT() asm volatile("s_waitcnt lgkmcnt(0)" ::: "memory")

namespace pg8 {
constexpr int BM = 256, BK = 64, HALF = 128, HTB = HALF * BK * 2, STAGE_BYTES = 8 * HTB, NXCD = 8, WGM = 8;
__host__ __device__ __forceinline__ int lds_byte(int r, int c) { const int st = (r >> 4) * 2 + (c >> 5), rr = r & 15, cc = c & 31, ob = rr * 64 + cc * 2; return st * 1024 + (ob ^ (((ob >> 9) & 1) << 5)); }
__host__ __device__ __forceinline__ void stage_rc(int b, int& R, int& C) { const int st = b / 1024, sb = b % 1024, swz = sb ^ (((sb >> 9) & 1) << 5); R = (st >> 1) * 16 + swz / 64; C = (st & 1) * 32 + (swz % 64) / 2; }
__host__ __device__ __forceinline__ int perm32(int rho) { const int n = rho >> 4, i = rho & 15; return 8 * (i >> 2) + 4 * n + (i & 3); }
struct Unit { int pm, pn; };
struct Gemm { const bf16_t* A; const bf16_t* Bt; int M, N, K; int lda; int a_pn_off; };
struct StaticOrder {
    int nM, nN, nwg, G, c;
    __device__ void init(int M, int N, int G_, int c_) { nM = M / BM; nN = N / BM; nwg = nM * nN; G = G_; c = c_; }
    __device__ bool next(int i, Unit& u) const {
        const long L = (long)i * G + c; if (L >= nwg) return false;
        int wgid = (int)L; { const int q = nwg / NXCD, r = nwg % NXCD, xcd = wgid % NXCD, off = wgid / NXCD; wgid = (xcd < r ? xcd * (q + 1) : r * (q + 1) + (xcd - r) * q) + off; }
        const int nig = WGM * nN, gid = wgid / nig, fm = gid * WGM, gsz = (nM - fm) < WGM ? (nM - fm) : WGM;
        u.pm = fm + ((wgid % nig) % gsz); u.pn = (wgid % nig) / gsz; return true;
    }
};

constexpr int RSTD_TBL_OFF = 131072 + 8192;
__device__ __forceinline__ void rstd_prep(const float* ss, int pm, int& prev_pm, int& tb, LAS float* tbl, int tid) {
    if (pm == prev_pm) return;
    tb ^= 1; prev_pm = pm;
    if (tid < 256) tbl[tb * 256 + tid] = row_rstd(ss, pm * 256 + tid);
}
typedef f32x4 Acc[2][2][4][2];
__device__ __forceinline__ void zero_acc(Acc& acc) {
#pragma unroll
    for (int a = 0; a < 2; ++a)
#pragma unroll
        for (int b = 0; b < 2; ++b)
#pragma unroll
            for (int m = 0; m < 4; ++m)
#pragma unroll
                for (int n = 0; n < 2; ++n) acc[a][b][m][n] = (f32x4){0.f, 0.f, 0.f, 0.f};
}
template <class Epi, bool ALIGN_EPI>
__device__ __forceinline__ void gemm_phase(LAS unsigned char* lds, const Gemm g, const StaticOrder& S, const Epi& E) {
    int tid = threadIdx.x; asm volatile("" : "+v"(tid));
    const int wid = __builtin_amdgcn_readfirstlane(tid >> 6), lane = tid & 63, wr = wid >> 2, wc = wid & 3, fr = lane & 15, fq = lane >> 4;
    const int K = g.K, nt = K / BK;
    unsigned voffA[2], voffB[2];
#pragma unroll
    for (int i = 0; i < 2; ++i) { int R, C; stage_rc(tid * 16 + i * 8192, R, C); const int Rb = Epi::PERM ? ((R & ~31) + perm32(R & 31)) : R;
        voffA[i] = (unsigned)(R * g.lda + C) * 2u; voffB[i] = (unsigned)(Rb * K + C) * 2u; }
    const size_t kstep = (size_t)(BK * 2);
    const size_t hstepA = (size_t)HALF * g.lda * 2, hstepB = (size_t)HALF * K * 2;
    const size_t tstepA = 2 * hstepA, tstepB = 2 * hstepB;
    const size_t pnoffA = (size_t)g.a_pn_off * 2;
    const unsigned ldsw = (unsigned)wid * 1024u;
    const int aoff = lds_byte(wr * 64 + fr, fq * 8), boff = lds_byte(wc * 32 + fr, fq * 8);
#define PG8_SA(b, h) (((b) * 2 + (h)) * HTB)
#define PG8_SB(b, h) ((4 + (b) * 2 + (h)) * HTB)
#define PG8_STAGE(bufoff, gbase, voff) do { _Pragma("unroll") for (int _i = 0; _i < 2; ++_i) \
        __builtin_amdgcn_global_load_lds((const unsigned*)((const char*)(gbase) + (voff)[_i]), (LAS unsigned*)(lds + (bufoff) + ldsw + _i * 8192), 16, 0, 0); } while (0)
#define PG8_LDA(dst, b, h) do { _Pragma("unroll") for (int m = 0; m < 4; ++m) _Pragma("unroll") for (int k = 0; k < 2; ++k) dst[m][k] = *(const LAS bf16x8*)(lds + PG8_SA(b, h) + aoff + m * 2048 + k * 1024); } while (0)
#define PG8_LDB(dst, b, h) do { _Pragma("unroll") for (int n = 0; n < 2; ++n) _Pragma("unroll") for (int k = 0; k < 2; ++k) dst[n][k] = *(const LAS bf16x8*)(lds + PG8_SB(b, h) + boff + n * 2048 + k * 1024); } while (0)
#define PG8_MMA(ai, bj, At, Bt) do { __builtin_amdgcn_s_setprio(1); _Pragma("unroll") for (int m = 0; m < 4; ++m) _Pragma("unroll") for (int n = 0; n < 2; ++n) _Pragma("unroll") for (int k = 0; k < 2; ++k) \
        acc[ai][bj][m][n] = __builtin_amdgcn_mfma_f32_16x16x32_bf16(Bt[n][k], At[m][k], acc[ai][bj][m][n], 0, 0, 0); __builtin_amdgcn_s_setprio(0); } while (0)
#define PG8_WAIT_V(n) asm volatile("s_waitcnt vmcnt(" #n ")" ::: "memory")
#define PG8_WAIT_L(n) asm volatile("s_waitcnt lgkmcnt(" #n ")" ::: "memory")
#define PG8_BAR __builtin_amdgcn_s_barrier()
#define PG8_SCHED __builtin_amdgcn_sched_barrier(0)
    Unit cur, nxt; int ui = 0;
    if (!S.next(0, cur)) return;
    f32x4 acc[2][2][4][2];
    E.init(acc, cur, wr, wc, fr, fq);
    int prev_pm = -1, tb = 0;
    E.prep(cur.pm, prev_pm, tb, (LAS float*)(lds + RSTD_TBL_OFF), tid);
    bf16x8 At[4][2], B0[2][2], B1[2][2];
    const char* cA = (const char*)g.A + (size_t)cur.pm * tstepA + (size_t)cur.pn * pnoffA; const char* cB = (const char*)g.Bt + (size_t)cur.pn * tstepB;
    PG8_STAGE(PG8_SB(0, 0), cB, voffB); PG8_STAGE(PG8_SB(0, 1), cB + hstepB, voffB); PG8_STAGE(PG8_SA(0, 0), cA, voffA); PG8_STAGE(PG8_SA(0, 1), cA + hstepA, voffA);
    if (wr == 1) PG8_BAR;
    PG8_WAIT_V(2); PG8_BAR;
    PG8_STAGE(PG8_SB(1, 0), cB + kstep, voffB); PG8_STAGE(PG8_SA(1, 0), cA + kstep, voffA); PG8_STAGE(PG8_SB(1, 1), cB + hstepB + kstep, voffB);
    PG8_WAIT_V(6); PG8_BAR;
    for (;;) {
        const bool has_next = S.next(ui + 1, nxt);
        const char* nA = has_next ? (const char*)g.A + (size_t)nxt.pm * tstepA + (size_t)nxt.pn * pnoffA : cA; const char* nB = has_next ? (const char*)g.Bt + (size_t)nxt.pn * tstepB : cB;
        for (int t = 0; t < nt; t += 2) {
            const bool last = (t == nt - 2);
            const char* a1 = cA + (size_t)(t + 1) * kstep;
            const char* a2 = last ? nA : cA + (size_t)(t + 2) * kstep; const char* b2 = last ? nB : cB + (size_t)(t + 2) * kstep;
            const char* a3 = a2 + kstep; const char* b3 = b2 + kstep;
            PG8_LDB(B0, 0, 0); PG8_LDB(B1, 0, 1); PG8_SCHED; PG8_LDA(At, 0, 0); PG8_STAGE(PG8_SA(1, 1), a1 + hstepA, voffA);
            PG8_WAIT_V(8); PG8_WAIT_L(0); PG8_BAR; PG8_MMA(0, 0, At, B0); PG8_MMA(0, 1, At, B1); PG8_BAR; PG8_SCHED;
            PG8_LDA(At, 0, 1); PG8_STAGE(PG8_SB(0, 0), b2, voffB); PG8_STAGE(PG8_SB(0, 1), b2 + hstepB, voffB); PG8_STAGE(PG8_SA(0, 0), a2, voffA);
            PG8_WAIT_V(8); PG8_WAIT_L(0); PG8_BAR; PG8_MMA(1, 0, At, B0); PG8_MMA(1, 1, At, B1); PG8_BAR; PG8_SCHED;
            PG8_LDB(B0, 1, 0); PG8_LDB(B1, 1, 1); PG8_SCHED; PG8_LDA(At, 1, 0); PG8_STAGE(PG8_SA(0, 1), a2 + hstepA, voffA);
            PG8_WAIT_V(8); PG8_WAIT_L(0); PG8_BAR; PG8_MMA(0, 0, At, B0); PG8_MMA(0, 1, At, B1); PG8_BAR; PG8_SCHED;
            PG8_LDA(At, 1, 1); PG8_STAGE(PG8_SB(1, 0), b3, voffB); PG8_STAGE(PG8_SB(1, 1), b3 + hstepB, voffB); PG8_STAGE(PG8_SA(1, 0), a3, voffA);
            PG8_WAIT_V(8); PG8_WAIT_L(0); PG8_BAR; PG8_MMA(1, 0, At, B0); PG8_MMA(1, 1, At, B1); PG8_BAR; PG8_SCHED;
        }
        if constexpr (ALIGN_EPI) { if (wr == 0) PG8_BAR; }
        E(acc, cur, wr, wc, fr, fq, (const LAS float*)(lds + RSTD_TBL_OFF) + tb * 256);
        if (!has_next) break;
        E.init(acc, nxt, wr, wc, fr, fq);
        E.prep(nxt.pm, prev_pm, tb, (LAS float*)(lds + RSTD_TBL_OFF), tid);
        cur = nxt; cA = nA; cB = nB; ++ui;
        if constexpr (ALIGN_EPI) { if (wr == 1) PG8_BAR; }
    }
    PG8_WAIT_V(0);
    if constexpr (!ALIGN_EPI) { if (wr == 0) PG8_BAR; }
    PG8_BAR;
#undef PG8_SA
#undef PG8_SB
#undef PG8_STAGE
#undef PG8_LDA
#undef PG8_LDB
#undef PG8_MMA
#undef PG8_WAIT_V
#undef PG8_WAIT_L
#undef PG8_BAR
#undef PG8_SCHED
}


struct EpiSwiGLU {
    static constexpr bool PERM = true;
    __device__ __forceinline__ void init(Acc& acc, const Unit&, int, int, int, int) const { zero_acc(acc); }
    __device__ __forceinline__ void prep(int pm, int& prev_pm, int& tb, LAS float* tbl, int tid) const { rstd_prep(ss, pm, prev_pm, tb, tbl, tid); }
    bf16_t* O; const float* ss;
    __device__ __forceinline__ void operator()(const Acc& acc, const Unit& u, int wr, int wc, int fr, int fq, const LAS float* rt) const {
        const int row0 = u.pm * BM + wr * 64 + fr, col0 = u.pn * 128 + wc * 32 + 8 * fq;
#pragma unroll
        for (int ai = 0; ai < 2; ++ai)
#pragma unroll
            for (int m = 0; m < 4; ++m) {
                const int row = row0 + ai * HALF + m * 16; const float r = rt[ai * HALF + wr * 64 + m * 16 + fr];
                float h[8];
#pragma unroll
                for (int n = 0; n < 2; ++n)
#pragma unroll
                    for (int e = 0; e < 4; ++e) { const float gg = acc[ai][0][m][n][e] * r, uu = acc[ai][1][m][n][e] * r; h[n * 4 + e] = gg * sigmoidf_(gg) * uu; }
                u32x4 w; w.x = cvtpk(h[0], h[1]); w.y = cvtpk(h[2], h[3]); w.z = cvtpk(h[4], h[5]); w.w = cvtpk(h[6], h[7]);
                __builtin_nontemporal_store(w, (u32x4*)(O + (size_t)row * FF + col0));
            }
    }
};
template <bool GATE> struct EpiResid {
    static constexpr bool PERM = false;
    const float* xin; float* xout; bf16_t* xb; float* ss_out; const float* ss_in; const float* bias; const bf16_t* Eb;
    __device__ __forceinline__ void prep(int pm, int& prev_pm, int& tb, LAS float* tbl, int tid) const { if (GATE) rstd_prep(ss_in, pm, prev_pm, tb, tbl, tid); }
    __device__ __forceinline__ void init(Acc& acc, const Unit& u, int wr, int wc, int fr, int fq) const {
        if (GATE) { zero_acc(acc); return; }
        const float* base = xin + (size_t)(u.pm * BM + wr * 64 + fr) * DM + u.pn * BM + wc * 32 + 4 * fq;
#pragma unroll
        for (int ai = 0; ai < 2; ++ai)
#pragma unroll
            for (int m = 0; m < 4; ++m)
#pragma unroll
                for (int bj = 0; bj < 2; ++bj)
#pragma unroll
                    for (int n = 0; n < 2; ++n) acc[ai][bj][m][n] = *(const f32x4*)(base + (size_t)(ai * HALF + m * 16) * DM + bj * HALF + n * 16);
    }
    __device__ __forceinline__ void operator()(const Acc& acc, const Unit& u, int wr, int wc, int fr, int fq, const LAS float* rt) const {
        const int row0 = u.pm * BM + wr * 64 + fr, col0 = u.pn * BM + wc * 32 + 4 * fq;
        f32x4 bvs[4];
        if (GATE) {
#pragma unroll
            for (int q = 0; q < 4; ++q) bvs[q] = *(const f32x4*)(bias + col0 + (q >> 1) * HALF + (q & 1) * 16);
        }
#pragma unroll
        for (int ai = 0; ai < 2; ++ai)
#pragma unroll
            for (int mp = 0; mp < 2; ++mp) {
                f32x4 xis[8]; u32x2 ebs[8];
                if (GATE) {
#pragma unroll
                    for (int k = 0; k < 8; ++k) { const size_t off = (size_t)(row0 + ai * HALF + (2 * mp + (k >> 2)) * 16) * DM + col0 + ((k >> 1) & 1) * HALF + (k & 1) * 16;
                        xis[k] = *(const f32x4*)(xin + off); ebs[k] = *(const u32x2*)(Eb + off); }
                }
#pragma unroll
                for (int mm = 0; mm < 2; ++mm) {
                    const int m = 2 * mp + mm; const int row = row0 + ai * HALF + m * 16; float r = 0.f; if (GATE) r = rt[ai * HALF + wr * 64 + m * 16 + fr];
                    float sq = 0.f;
#pragma unroll
                    for (int bj = 0; bj < 2; ++bj)
#pragma unroll
                        for (int n = 0; n < 2; ++n) {
                            const int c = col0 + bj * HALF + n * 16; const size_t off = (size_t)row * DM + c;
                            const f32x4 a = acc[ai][bj][m][n]; f32x4 xo;
                            if (GATE) { const int k = mm * 4 + bj * 2 + n; const f32x4 xi = xis[k]; const f32x4 bv = bvs[bj * 2 + n]; const u32x2 eb = ebs[k];
                                xo[0] = xi[0] + sigmoidf_(a[0] * r + bv[0]) * bflo(eb.x); xo[1] = xi[1] + sigmoidf_(a[1] * r + bv[1]) * bfhi(eb.x);
                                xo[2] = xi[2] + sigmoidf_(a[2] * r + bv[2]) * bflo(eb.y); xo[3] = xi[3] + sigmoidf_(a[3] * r + bv[3]) * bfhi(eb.y); }
                            else xo = a;
                            __builtin_nontemporal_store(xo, (f32x4*)(xout + off));
                            u32x2 w; w.x = cvtpk(xo[0], xo[1]); w.y = cvtpk(xo[2], xo[3]); *(u32x2*)(xb + off) = w;
                            sq += (xo[0] * xo[0] + xo[1] * xo[1]) + (xo[2] * xo[2] + xo[3] * xo[3]);
                        }
                    sq += __shfl_xor(sq, 16); sq += __shfl_xor(sq, 32);
                    if (fq == 0) ss_out[(size_t)row * 16 + u.pn * 4 + wc] = sq;
                }
            }
    }
};
struct EpiProj {
    static constexpr bool PERM = true;
    __device__ __forceinline__ void init(Acc& acc, const Unit&, int, int, int, int) const { zero_acc(acc); }
    __device__ __forceinline__ void prep(int pm, int& prev_pm, int& tb, LAS float* tbl, int tid) const { rstd_prep(ss, pm, prev_pm, tb, tbl, tid); }
    bf16_t* O; const float* ss; const float* qn; const float* kn; LAS float* P;
    __device__ __forceinline__ void operator()(const Acc& acc, const Unit& u, int wr, int wc, int fr, int fq, const LAS float* rt) const {
        const int row0 = u.pm * BM + wr * 64 + fr; int colt = u.pn * BM; const int t = colt >> 10; colt -= t << 10;
        bf16_t* base = O + (size_t)t * ((size_t)T * DM); const int col0 = colt + wc * 32 + 8 * fq;
        if (t == 2 || t == 3) {
            float rx[8];
#pragma unroll
            for (int ai = 0; ai < 2; ++ai)
#pragma unroll
                for (int m = 0; m < 4; ++m) {
                    const int rl = ai * HALF + wr * 64 + m * 16 + fr; const float r = rt[rl]; rx[ai * 4 + m] = r;
#pragma unroll
                    for (int bj = 0; bj < 2; ++bj) { const f32x4 v0 = acc[ai][bj][m][0] * r, v1 = acc[ai][bj][m][1] * r;
                        float s = (v0[0] * v0[0] + v0[1] * v0[1]) + (v0[2] * v0[2] + v0[3] * v0[3]) + (v1[0] * v1[0] + v1[1] * v1[1]) + (v1[2] * v1[2] + v1[3] * v1[3]);
                        s += __shfl_xor(s, 16); s += __shfl_xor(s, 32);
                        if (fq == 0) P[(rl * 2 + bj) * 4 + wc] = s; }
                }
            asm volatile("s_waitcnt lgkmcnt(0)" ::: "memory"); __builtin_amdgcn_s_barrier(); asm volatile("" ::: "memory");
            const float* gp = (t == 2 ? qn : kn) + wc * 32 + 8 * fq; const f32x4 g0 = *(const f32x4*)gp, g1 = *(const f32x4*)(gp + 4);
            const float qs = (t == 2) ? 0.08838834764831845f * LOG2E : 1.f;
#pragma unroll
            for (int ai = 0; ai < 2; ++ai)
#pragma unroll
                for (int m = 0; m < 4; ++m) {
                    const int rl = ai * HALF + wr * 64 + m * 16 + fr; const float r = rx[ai * 4 + m];
#pragma unroll
                    for (int bj = 0; bj < 2; ++bj) { const f32x4 pp = *(const LAS f32x4*)(P + (rl * 2 + bj) * 4);
                        const float rn = rsqrtf(((pp[0] + pp[1]) + (pp[2] + pp[3])) * (1.f / HD) + EPS) * qs * r;
                        const f32x4 v0 = acc[ai][bj][m][0] * rn * g0, v1 = acc[ai][bj][m][1] * rn * g1;
                        u32x4 w; w.x = cvtpk(v0[0], v0[1]); w.y = cvtpk(v0[2], v0[3]); w.z = cvtpk(v1[0], v1[1]); w.w = cvtpk(v1[2], v1[3]);
                        __builtin_nontemporal_store(w, (u32x4*)(base + (size_t)(u.pm * BM + rl) * DM + col0 + bj * HALF)); }
                }
            return;
        }
#pragma unroll
        for (int ai = 0; ai < 2; ++ai)
#pragma unroll
            for (int m = 0; m < 4; ++m) {
                const int row = row0 + ai * HALF + m * 16; const float r = rt[ai * HALF + wr * 64 + m * 16 + fr];
#pragma unroll
                for (int bj = 0; bj < 2; ++bj) { const f32x4 v0 = acc[ai][bj][m][0] * r, v1 = acc[ai][bj][m][1] * r;
                    u32x4 w; w.x = cvtpk(v0[0], v0[1]); w.y = cvtpk(v0[2], v0[3]); w.z = cvtpk(v1[0], v1[1]); w.w = cvtpk(v1[2], v1[3]);
                    __builtin_nontemporal_store(w, (u32x4*)(base + (size_t)row * DM + col0 + bj * HALF)); }
            }
    }
};
struct EpiPlain {
    static constexpr bool PERM = true;
    __device__ __forceinline__ void init(Acc& acc, const Unit&, int, int, int, int) const { zero_acc(acc); }
    __device__ __forceinline__ void prep(int, int&, int&, LAS float*, int) const {}
    bf16_t* O;
    __device__ __forceinline__ void operator()(const Acc& acc, const Unit& u, int wr, int wc, int fr, int fq, const LAS float* rt) const {
        const int row0 = u.pm * BM + wr * 64 + fr, col0 = u.pn * BM + wc * 32 + 8 * fq;
#pragma unroll
        for (int ai = 0; ai < 2; ++ai)
#pragma unroll
            for (int m = 0; m < 4; ++m) {
                const int row = row0 + ai * HALF + m * 16;
#pragma unroll
                for (int bj = 0; bj < 2; ++bj) { const f32x4 v0 = acc[ai][bj][m][0], v1 = acc[ai][bj][m][1];
                    u32x4 w; w.x = cvtpk(v0[0], v0[1]); w.y = cvtpk(v0[2], v0[3]); w.z = cvtpk(v1[0], v1[1]); w.w = cvtpk(v1[2], v1[3]);
                    __builtin_nontemporal_store(w, (u32x4*)(O + (size_t)row * DM + col0 + bj * HALF)); }
            }
    }
};
struct EpiGate {
    static constexpr bool PERM = true;
    __device__ __forceinline__ void init(Acc& acc, const Unit&, int, int, int, int) const { zero_acc(acc); }
    __device__ __forceinline__ void prep(int, int&, int&, LAS float*, int) const {}
    const bf16_t* rxc; bf16_t* L; bf16_t* U; const float* ba; const float* bx; const float* sp8;
    __device__ __forceinline__ void operator()(const Acc& acc, const Unit& u, int wr, int wc, int fr, int fq, const LAS float* rt) const {
        const int row0 = u.pm * BM + wr * 64 + fr, c0 = u.pn * 128 + wc * 32 + 8 * fq;
        asm volatile("" ::: "memory");
        u32x4 xq0 = *(const u32x4*)(rxc + (size_t)row0 * DM + c0), xq1 = *(const u32x4*)(rxc + (size_t)(row0 + 16) * DM + c0);
#pragma unroll
        for (int ai = 0; ai < 2; ++ai)
#pragma unroll
            for (int m = 0; m < 4; ++m) {
                const int row = row0 + ai * HALF + m * 16; const size_t off = (size_t)row * DM + c0;
                const u32x4 xr = xq0; xq0 = xq1;
                { const int k2 = ai * 4 + m + 2; if (k2 < 8) xq1 = *(const u32x4*)(rxc + (size_t)(row0 + (k2 >> 2) * HALF + (k2 & 3) * 16) * DM + c0); }
                const float xc[8] = {bflo(xr.x), bfhi(xr.x), bflo(xr.y), bfhi(xr.y), bflo(xr.z), bfhi(xr.z), bflo(xr.w), bfhi(xr.w)};
                unsigned wl[4], wu[4];
#pragma unroll
                for (int n = 0; n < 2; ++n) {
                    const f32x4 vba = *(const f32x4*)(ba + c0 + 4 * n), vbx = *(const f32x4*)(bx + c0 + 4 * n), vsp = *(const f32x4*)(sp8 + c0 + 4 * n);
                    float la[4], uu[4];
#pragma unroll
                    for (int e = 0; e < 4; ++e) {
                        const float rg = sigmoidf_(acc[ai][0][m][n][e] + vba[e]), ig = sigmoidf_(acc[ai][1][m][n][e] + vbx[e]);
                        const float l = -vsp[e] * rg, y = 2.f * l;
                        const float om = (y > -0.01f) ? -y * (1.f + y * (0.5f + y * (1.f / 6.f))) : 1.f - __builtin_amdgcn_exp2f(y * LOG2E);
                        la[e] = l; uu[e] = __builtin_amdgcn_sqrtf(om) * ig * xc[n * 4 + e]; }
                    wl[2 * n] = cvtpk(la[0], la[1]); wl[2 * n + 1] = cvtpk(la[2], la[3]); wu[2 * n] = cvtpk(uu[0], uu[1]); wu[2 * n + 1] = cvtpk(uu[2], uu[3]);
                }
                __builtin_nontemporal_store((u32x4){wl[0], wl[1], wl[2], wl[3]}, (u32x4*)(L + off)); __builtin_nontemporal_store((u32x4){wu[0], wu[1], wu[2], wu[3]}, (u32x4*)(U + off));
                asm volatile("" ::: "memory");
            }
    }
};
template <bool ADD> struct EpiMerge {
    static constexpr bool PERM = true;
    __device__ __forceinline__ void init(Acc& acc, const Unit&, int, int, int, int) const { zero_acc(acc); }
    __device__ __forceinline__ void prep(int, int&, int&, LAS float*, int) const {}
    const bf16_t* Gt; const float* mb; const bf16_t* prev; bf16_t* O;
    __device__ __forceinline__ void operator()(const Acc& acc, const Unit& u, int wr, int wc, int fr, int fq, const LAS float* rt) const {
        const int row0 = u.pm * BM + wr * 64 + fr, col0 = u.pn * BM + wc * 32 + 8 * fq;
#pragma unroll
        for (int bj = 0; bj < 2; ++bj) {
            const int c = col0 + bj * HALF; float vmb[8];
#pragma unroll
            for (int j = 0; j < 8; ++j) vmb[j] = mb[c + j];
#pragma unroll
            for (int ai = 0; ai < 2; ++ai) {
            asm volatile("" ::: "memory");
            u32x4 gr[4], pr[4];
#pragma unroll
            for (int k = 0; k < 4; ++k) { const size_t off = (size_t)(row0 + ai * HALF + k * 16) * DM + c;
                gr[k] = *(const u32x4*)(Gt + off); if (ADD) pr[k] = *(const u32x4*)(prev + off); }
#pragma unroll
            for (int k = 0; k < 4; ++k) {
                const int m = k; const size_t off = (size_t)(row0 + ai * HALF + m * 16) * DM + c;
                const float gv[8] = {bflo(gr[k].x), bfhi(gr[k].x), bflo(gr[k].y), bfhi(gr[k].y), bflo(gr[k].z), bfhi(gr[k].z), bflo(gr[k].w), bfhi(gr[k].w)};
                float pv[8] = {0.f, 0.f, 0.f, 0.f, 0.f, 0.f, 0.f, 0.f};
                if (ADD) { pv[0] = bflo(pr[k].x); pv[1] = bfhi(pr[k].x); pv[2] = bflo(pr[k].y); pv[3] = bfhi(pr[k].y); pv[4] = bflo(pr[k].z); pv[5] = bfhi(pr[k].z); pv[6] = bflo(pr[k].w); pv[7] = bfhi(pr[k].w); }
                float o[8];
#pragma unroll
                for (int n = 0; n < 2; ++n)
#pragma unroll
                    for (int e = 0; e < 4; ++e) { const int j = n * 4 + e; o[j] = pv[j] + sigmoidf_(gv[j] + vmb[j]) * acc[ai][bj][m][n][e]; }
                u32x4 w; w.x = cvtpk(o[0], o[1]); w.y = cvtpk(o[2], o[3]); w.z = cvtpk(o[4], o[5]); w.w = cvtpk(o[6], o[7]);
                *(u32x4*)(O + off) = w;
            }
            }
        }
    }
};
}

namespace att {
using bf16 = __hip_bfloat16;
constexpr int NW = 8, QBLK = 32, KVBLK = 64, QB = NW * QBLK, D = 128, LD = 1024;
constexpr int SHM_V = KVBLK * D * 2, SHM_K = KVBLK * D * 2;
constexpr int OFF_WS = 2 * SHM_V + 2 * SHM_K, OFF_KB = OFF_WS + NW * 64 * 4, ATT_LDS = OFF_KB + 2 * 64 * 4;
constexpr float THR = 8.f;
#define KSWZ(row, colB) ((row) * 256 + ((colB) ^ (((row) & 7) << 4)))
#define SBAR() __builtin_amdgcn_sched_barrier(0)
__device__ __forceinline__ int v_st(int k, int c) { const int kk = (k & ~0xC) | ((k & 4) << 1) | ((k & 8) >> 1); return ((kk >> 3) * 4 + (c >> 5)) * 512 + ((kk & 7) * 32 + (c & 31)) * 2; }
__device__ __forceinline__ int v_rd_base(int lane) { return ((lane & 3) << 3) | (((lane >> 2) & 3) << 6) | (((lane >> 4) & 1) << 5) | (((lane >> 5) & 1) << 8); }
constexpr int v_rd_off(int d0, int ks, int half) { return d0 * 512 + ks * 4096 + half * 2048; }
__device__ __forceinline__ int crow(int r, int hi) { return (r & 3) + 8 * (r >> 2) + 4 * hi; }
__device__ __forceinline__ bf16x8 load8(const bf16* p) { return *reinterpret_cast<const bf16x8*>(p); }
__device__ __forceinline__ void mask_tile(f32x16& p0, f32x16& p1, int dq) {
    const float NEG = -__builtin_inff();
#pragma unroll
    for (int r = 0; r < 16; ++r) {
        const int c = (r & 3) + 8 * (r >> 2);
        if (dq - c < 0) p0[r] = NEG;
        if (dq - c - 32 < 0) p1[r] = NEG;
    }
}
__device__ __forceinline__ void partialSM(f32x16& p0, f32x16& p1, float& m_reg, float& mn, float& alpha) {
    float pmax = p0[0];
#pragma unroll
    for (int r = 1; r < 16; ++r) pmax = fmaxf(pmax, p0[r]);
#pragma unroll
    for (int r = 0; r < 16; ++r) pmax = fmaxf(pmax, p1[r]);
    { auto rr = __builtin_amdgcn_permlane32_swap(__float_as_uint(pmax), __float_as_uint(pmax), false, false);
      pmax = fmaxf(__uint_as_float(rr[0]), __uint_as_float(rr[1])); }
    if (__builtin_expect(__all((pmax - m_reg) <= THR), 1)) { mn = m_reg; alpha = 1.f; }
    else { mn = fmaxf(m_reg, pmax); alpha = __builtin_amdgcn_exp2f(m_reg - mn); m_reg = mn; }
#pragma unroll
    for (int r = 0; r < 16; ++r) p0[r] = p0[r] - mn;
#pragma unroll
    for (int r = 0; r < 16; ++r) p1[r] = p1[r] - mn;
#pragma unroll
    for (int r = 0; r < 16; ++r) p0[r] = __builtin_amdgcn_exp2f(p0[r]);
}
__device__ __forceinline__ void finishSM(f32x16& p0, f32x16& p1, float alpha, float& l_reg, bf16x8& pa0, bf16x8& pa1, bf16x8& pa2, bf16x8& pa3) {
#pragma unroll
    for (int r = 0; r < 16; ++r) p1[r] = __builtin_amdgcn_exp2f(p1[r]);
    float ps = 0;
#pragma unroll
    for (int r = 0; r < 16; ++r) ps += p0[r];
#pragma unroll
    for (int r = 0; r < 16; ++r) ps += p1[r];
    { auto rr = __builtin_amdgcn_permlane32_swap(__float_as_uint(ps), __float_as_uint(ps), false, false);
      ps = __uint_as_float(rr[0]) + __uint_as_float(rr[1]); }
    l_reg = l_reg * alpha + ps;
#define PK4(P, B_, OUT) do { unsigned a0 = cvtpk(P[B_+0], P[B_+1]), a1 = cvtpk(P[B_+2], P[B_+3]);                          \
        unsigned b0 = cvtpk(P[B_+4], P[B_+5]), b1 = cvtpk(P[B_+6], P[B_+7]);                                             \
        auto r0 = __builtin_amdgcn_permlane32_swap(a0, b0, false, false); auto r1 = __builtin_amdgcn_permlane32_swap(a1, b1, false, false); \
        u32x4 w = {r0[0], r1[0], r0[1], r1[1]}; OUT = *reinterpret_cast<bf16x8*>(&w); } while (0)
    PK4(p0, 0, pa0); PK4(p0, 8, pa1); PK4(p1, 0, pa2); PK4(p1, 8, pa3);
#undef PK4
}
template <int KB>
__device__ __forceinline__ void qkt(f32x16& p0, f32x16& p1, const char* K_lds, const float* kbias, int r32, int hi, const bf16x8* qr) {
    { const float* kb_ = kbias + KB * 64 + 4 * hi;
#pragma unroll
      for (int g = 0; g < 4; ++g) { const f32x4 b0 = *(const f32x4*)(kb_ + 8 * g), b1 = *(const f32x4*)(kb_ + 32 + 8 * g);
#pragma unroll
          for (int j = 0; j < 4; ++j) { p0[4 * g + j] = b0[j]; p1[4 * g + j] = b1[j]; } } }
    const char* kb[4];
#pragma unroll
    for (int dd = 0; dd < 4; ++dd) kb[dd] = K_lds + KB * SHM_K + KSWZ(r32, (dd * 16 + hi * 8) * 2);
#pragma unroll
    for (int d0 = 0; d0 < 8; ++d0) { const char* a = kb[d0 & 3] + (d0 >> 2) * 128;
        bf16x8 b0 = *reinterpret_cast<const bf16x8*>(a);
        bf16x8 b1 = *reinterpret_cast<const bf16x8*>(a + 32 * 256);
        p0 = __builtin_amdgcn_mfma_f32_32x32x16_bf16(b0, qr[d0], p0, 0, 0, 0);
        p1 = __builtin_amdgcn_mfma_f32_32x32x16_bf16(b1, qr[d0], p1, 0, 0, 0); }
}
template <int VB>
__device__ __forceinline__ void pv_tile(f32x16* o, int vb0, bf16x8 pa0, bf16x8 pa1, bf16x8 pa2, bf16x8 pa3) {
#define TRRD(dst, off) asm volatile("ds_read_b64_tr_b16 %0, %1 offset:%2" : "=&v"(dst) : "v"(vb0), "i"(off) : "memory")
#define PV_D0(d0) do { s16x4 l0, l1, l2, l3, h0, h1, h2, h3; constexpr int b_ = VB * SHM_V + v_rd_off(d0, 0, 0); \
        TRRD(l0, b_); TRRD(h0, b_ + 2048); TRRD(l1, b_ + 4096); TRRD(h1, b_ + 6144); TRRD(l2, b_ + 8192); TRRD(h2, b_ + 10240); TRRD(l3, b_ + 12288); TRRD(h3, b_ + 14336); \
        asm volatile("s_waitcnt lgkmcnt(0)" ::: "memory"); SBAR(); \
        o[d0] = __builtin_amdgcn_mfma_f32_32x32x16_bf16(pa0, (bf16x8){l0[0], l0[1], l0[2], l0[3], h0[0], h0[1], h0[2], h0[3]}, o[d0], 0, 0, 0);   \
        o[d0] = __builtin_amdgcn_mfma_f32_32x32x16_bf16(pa1, (bf16x8){l1[0], l1[1], l1[2], l1[3], h1[0], h1[1], h1[2], h1[3]}, o[d0], 0, 0, 0);   \
        o[d0] = __builtin_amdgcn_mfma_f32_32x32x16_bf16(pa2, (bf16x8){l2[0], l2[1], l2[2], l2[3], h2[0], h2[1], h2[2], h2[3]}, o[d0], 0, 0, 0);   \
        o[d0] = __builtin_amdgcn_mfma_f32_32x32x16_bf16(pa3, (bf16x8){l3[0], l3[1], l3[2], l3[3], h3[0], h3[1], h3[2], h3[3]}, o[d0], 0, 0, 0); } while (0)
    PV_D0(0); PV_D0(1); PV_D0(2); PV_D0(3);
#undef PV_D0
#undef TRRD
}
struct BlockRef { const bf16* Q; const bf16* K; const bf16* V; bf16* O; const float* ND; int P0; int jlo; };
struct Seam { bf16x8 qr[8]; bf16x8 st_v0, st_v1, st_k0, st_k1; };
#define ROW(p, k0, rr) ((p) + (size_t)((k0) + (rr)) * LD + sc)
#define VMW() asm volatile("s_waitcnt vmcnt(0)" ::: "memory")
#define VMWN(n) asm volatile("s_waitcnt vmcnt(%0)" :: "i"(n) : "memory")
#define SLOAD_H(Kp, Vp, NDp, k0, bf) do { S.st_v0 = load8(ROW(Vp, k0, sr)); S.st_v1 = load8(ROW(Vp, k0, 32 + sr));              \
                         S.st_k0 = load8(ROW(Kp, k0, sr)); S.st_k1 = load8(ROW(Kp, k0, 32 + sr));                              \
                         if (wid == 0) __builtin_amdgcn_global_load_lds((const unsigned*)((NDp) + (k0) + lane), (LAS unsigned*)(kbias3 + (bf) * 64), 4, 0, 0); } while (0)
#define SWRITE_HK(bf) do { *(bf16x8*)(K_lds + (bf) * SHM_K + kws) = S.st_k0; *(bf16x8*)(K_lds + (bf) * SHM_K + kws + 32 * 256) = S.st_k1; } while (0)
#define SWRITE_HV(bf) do { *(bf16x8*)(V_lds + (bf) * SHM_V + vst0) = S.st_v0; *(bf16x8*)(V_lds + (bf) * SHM_V + vst1) = S.st_v1; } while (0)
#define SWRITE_H(bf) do { SWRITE_HV(bf); SWRITE_HK(bf); } while (0)
__device__ __forceinline__ void attn_prime(const BlockRef& cur, char* lds, Seam& S) {
    int tid = threadIdx.x; asm volatile("" : "+v"(tid)); const int wid = __builtin_amdgcn_readfirstlane(tid >> 6), lane = tid & 63, r32 = lane & 31, hi = lane >> 5;
    const int sr = tid >> 4, sc = (tid & 15) * 8, kws = KSWZ(sr, sc * 2); char* K_lds = lds + 2 * SHM_V; LAS float* kbias3 = (LAS float*)(LAS char*)lds + OFF_KB / 4;
#pragma unroll
    for (int d0 = 0; d0 < 8; ++d0) S.qr[d0] = load8(cur.Q + (size_t)(wid * QBLK + r32) * LD + d0 * 16 + hi * 8);
    SLOAD_H(cur.K, cur.V, cur.ND, cur.P0 + QB - KVBLK, 0); VMW(); SWRITE_HK(0);
    __syncthreads();
}
__device__ __forceinline__ void attn_block(const BlockRef& cur, const BlockRef& nxt, char* lds, Seam& S) {
    int tid = threadIdx.x; asm volatile("" : "+v"(tid)); const int wid = __builtin_amdgcn_readfirstlane(tid >> 6), lane = tid & 63, r32 = lane & 31, hi = lane >> 5;
    const int j_lo = cur.jlo, NT = (cur.P0 + QB) / KVBLK - j_lo;
    const int qlo = cur.P0 + wid * QBLK, qm = qlo + r32 - 4 * hi;
    char* V_lds = lds; char* K_lds = lds + 2 * SHM_V; const float* kbias = (const float*)(lds + OFF_KB); LAS float* kbias3 = (LAS float*)(LAS char*)lds + OFF_KB / 4;
    float* ws = (float*)(lds + OFF_WS) + wid * 64; float* li_l = ws, * al_l = ws + 32;
    float m_reg = -1e30f, l_reg = 0; f32x16 o[4] = {};
    const int sr = tid >> 4, sc = (tid & 15) * 8, vst0 = v_st(sr, sc), vst1 = v_st(32 + sr, sc), kws = KSWZ(sr, sc * 2);
    const int vb0 = (int)(uintptr_t)V_lds + v_rd_base(lane);
    const bf16* Kh = cur.K; const bf16* Vh = cur.V; const float* NDh = cur.ND;
#define RESC(a) do { if (__any((a) < 1.f)) { if (hi == 0) al_l[r32] = (a); asm volatile("s_waitcnt lgkmcnt(0)" ::: "memory");              \
                     for (int d_ = 0; d_ < 4; ++d_) for (int r = 0; r < 16; ++r) o[d_][r] *= al_l[crow(r, hi)]; } } while (0)
#define KBASE(t) ((j_lo + NT - 1 - (t)) * KVBLK)
#define MASKT(P0_, P1_, t) do { const int kb_ = KBASE(t); if (kb_ + KVBLK - 1 > qlo) mask_tile(P0_, P1_, qm - kb_); } while (0)
#define SEAM_K0() do { VMWN(8); SWRITE_HK(0); SBAR(); } while (0)
    f32x16 pA0, pA1, pB0, pB1; float mnA, mnB, alA, alB; bf16x8 pa0, pa1, pa2, pa3;
    SWRITE_HV(0); SBAR();
    SLOAD_H(Kh, Vh, NDh, KBASE(1), 1);
    SBAR(); qkt<0>(pA0, pA1, K_lds, kbias, r32, hi, S.qr);
    MASKT(pA0, pA1, 0); partialSM(pA0, pA1, m_reg, mnA, alA);
    VMW(); SWRITE_H(1);
    __syncthreads();
#define HALF_STEP(PX0, PX1, mnX, alX, PY0, PY1, alY, t, KB, VB, SB) do {                                                      \
        SBAR(); qkt<KB>(PX0, PX1, K_lds, kbias, r32, hi, S.qr);                                                               \
        finishSM(PY0, PY1, alY, l_reg, pa0, pa1, pa2, pa3); SBAR();                                                           \
        if ((t) + 1 < NT) { SLOAD_H(Kh, Vh, NDh, KBASE((t) + 1), SB); SBAR(); }                                               \
        pv_tile<VB>(o, vb0, pa0, pa1, pa2, pa3); MASKT(PX0, PX1, (t)); partialSM(PX0, PX1, m_reg, mnX, alX);                  \
        __syncthreads();                                                                                                      \
        if ((t) + 1 < NT) { VMW(); SWRITE_H(SB); }                                                                            \
        RESC(alX); __syncthreads(); } while (0)
    for (int t = 1; t + 1 < NT; t += 2) {
        HALF_STEP(pB0, pB1, mnB, alB, pA0, pA1, alA, t, 1, 0, 0);
        HALF_STEP(pA0, pA1, mnA, alA, pB0, pB1, alB, t + 1, 0, 1, 1);
    }
    SBAR(); qkt<1>(pB0, pB1, K_lds, kbias, r32, hi, S.qr); SBAR();
    SLOAD_H(nxt.K, nxt.V, nxt.ND, nxt.P0 + QB - KVBLK, 0); SBAR();
#pragma unroll
    for (int d0 = 0; d0 < 8; ++d0) S.qr[d0] = load8(nxt.Q + (size_t)(wid * QBLK + r32) * LD + d0 * 16 + hi * 8);
    SBAR();
    finishSM(pA0, pA1, alA, l_reg, pa0, pa1, pa2, pa3); SBAR();
    pv_tile<0>(o, vb0, pa0, pa1, pa2, pa3);
    MASKT(pB0, pB1, NT - 1); partialSM(pB0, pB1, m_reg, mnB, alB); __syncthreads(); RESC(alB);
    finishSM(pB0, pB1, alB, l_reg, pa0, pa1, pa2, pa3); SBAR(); pv_tile<1>(o, vb0, pa0, pa1, pa2, pa3);
    SBAR(); SEAM_K0();
    if (hi == 0) li_l[r32] = l_reg; asm volatile("s_waitcnt lgkmcnt(0)" ::: "memory");
    float rli[16];
#pragma unroll
    for (int r = 0; r < 16; ++r) rli[r] = __builtin_amdgcn_rcpf(li_l[crow(r, hi)]);
    bf16* Ow = cur.O + (size_t)(wid * QBLK) * LD;
#pragma unroll
    for (int r = 0; r < 16; ++r) { const int orow = crow(r, hi);
#pragma unroll
        for (int d0 = 0; d0 < 4; ++d0) { const float v = o[d0][r] * rli[r];
            const float vn = __shfl_xor(v, 1);
            if ((r32 & 1) == 0) *(unsigned*)(Ow + (size_t)orow * LD + d0 * 32 + r32) = cvtpk(v, vn); } }
    __syncthreads();
#undef RESC
#undef KBASE
#undef MASKT
#undef SEAM_K0
#undef HALF_STEP
}
#undef ROW
#undef VMW
#undef VMWN
#undef SLOAD_H
#undef SWRITE_HK
#undef SWRITE_HV
#undef SWRITE_H
__device__ __forceinline__ float ld_agent(const float* p) { const float v = __hip_atomic_load(p, __ATOMIC_RELAXED, __HIP_MEMORY_SCOPE_AGENT); return __uint_as_float(__builtin_amdgcn_readfirstlane(__float_as_uint(v))); }
__device__ __forceinline__ BlockRef mk_ref(int i, float C, const bf16* Q, const bf16* K, const bf16* V, bf16* O, const float* ND) {
    const int bh = i & 31, qb = 31 - (i >> 5), b = bh >> 3, h = bh & 7;
    const size_t hoff = (size_t)b * SEQ * LD + (size_t)h * D;
    BlockRef r; r.P0 = qb * QB;
    r.Q = Q + hoff + (size_t)r.P0 * LD; r.O = O + hoff + (size_t)r.P0 * LD; r.K = K + hoff; r.V = V + hoff; r.ND = ND + (size_t)bh * SEQ;
    const float thr = ld_agent(r.ND + r.P0) - C;
    int lo = 0, hi = r.P0 / KVBLK;
    while (lo < hi) { const int mid = (lo + hi) >> 1; if (ld_agent(r.ND + mid * KVBLK + KVBLK - 1) >= thr) hi = mid; else lo = mid + 1; }
    r.jlo = __builtin_amdgcn_readfirstlane(lo & ~1);
    return r;
}
__device__ __forceinline__ void attn_phase(char* lds, const bf16* Q, const bf16* K, const bf16* V, bf16* O, const float* ND, unsigned* ctr, const float* qn, const float* kn) {
    constexpr int total = NB * NH * 32;
    volatile int* slot = (volatile int*)(lds + ATT_LDS);
    int tid = threadIdx.x; asm volatile("" : "+v"(tid));
    float C;
    { float gq = 0.f, gk = 0.f;
      for (int j = 0; j < D; ++j) { gq = fmaxf(gq, fabsf(qn[j])); gk = fmaxf(gk, fabsf(kn[j])); }
      C = 2.f * 16.65f * gq * gk + 32.f + ((PROBE == 7) ? 75.f : 0.f); C = __uint_as_float(__builtin_amdgcn_readfirstlane(__float_as_uint(C))); }
    if (tid == 0) slot[0] = (int)atomicAdd(ctr, 1u);
    __syncthreads();
    int L = slot[0]; L = __builtin_amdgcn_readfirstlane(L);
    if (L >= total) return;
    BlockRef cur = mk_ref(L, C, Q, K, V, O, ND);
    if (tid == 0) slot[1] = (int)atomicAdd(ctr, 1u);
    Seam S;
    attn_prime(cur, lds, S);
    for (int it = 1;; ++it) {
        int Ln = slot[it & 1]; Ln = __builtin_amdgcn_readfirstlane(Ln);
        const bool last = Ln >= total;
        const BlockRef nxt = last ? cur : mk_ref(Ln, C, Q, K, V, O, ND);
        if (!last && tid == 0) slot[(it + 1) & 1] = (int)atomicAdd(ctr, 1u);
        attn_block(cur, nxt, lds, S);
        if (last) break;
        cur = nxt;
    }
}
#undef KSWZ
#undef SBAR
}


#define XB_TMO      128
#define XB_XCNT(j)  (256  + 64 * (j))
#define XB_XSUB(j)  (1280 + 64 * (j))
#define XB_XGEN(j)  (2304 + 64 * (j))
#define XB_TOP      3328
#define XB_TOPGEN   3392
#define XCD_BAR_WORDS 3456
#define XB_SPIN_CAP (1u << 22)
constexpr size_t WS_BAR = WS_VEC + 524288;
constexpr int LDS_BARST = LDS_BYTES - 64;
__device__ __forceinline__ unsigned xb_ld(unsigned* p)              { return __hip_atomic_load(p, __ATOMIC_RELAXED, __HIP_MEMORY_SCOPE_AGENT); }
__device__ __forceinline__ unsigned xb_add(unsigned* p, unsigned v) { return __hip_atomic_fetch_add(p, v, __ATOMIC_RELAXED, __HIP_MEMORY_SCOPE_AGENT); }
__device__ __forceinline__ unsigned xb_xcc_id() { return (unsigned)__builtin_amdgcn_s_getreg((3 << 11) | 20) & 0xFu; }
#define XB_SPIN(cond, bar) do { unsigned _sp = 0; while (cond) { __builtin_amdgcn_s_sleep(1); \
    if ((++_sp & 255u) == 0u) { if (xb_ld(&(bar)[XB_TMO])) break; if (_sp > XB_SPIN_CAP) { atomicAdd(&(bar)[XB_TMO], 1u); break; } } } } while (0)
__device__ __forceinline__ void xcd_barrier_complete(unsigned* bar, unsigned x, unsigned& nloc, unsigned& nx) {
    const unsigned G = gridDim.x * gridDim.y * gridDim.z;
    unsigned sum, cnt, mine, sp = 0u;
    for (;;) {
        sum = 0u; cnt = 0u; mine = 0u;
#pragma unroll
        for (unsigned j = 0; j < 16; ++j) { const unsigned c = xb_ld(&bar[XB_XCNT(j)]); sum += c; cnt += (c > 0u) ? 1u : 0u; mine = (j == x) ? c : mine; }
        if (sum == G) break;
        __builtin_amdgcn_s_sleep(1);
        if ((++sp & 255u) == 0u) { if (xb_ld(&bar[XB_TMO])) break; if (sp > XB_SPIN_CAP) { atomicAdd(&bar[XB_TMO], 1u); break; } }
    }
    nloc = mine > 0u ? mine : 1u; nx = cnt > 0u ? cnt : 1u;
}
__device__ __forceinline__ void xcd_barrier(unsigned* bar, volatile LAS unsigned* st) {
    asm volatile("s_waitcnt vmcnt(0)" ::: "memory");
    __syncthreads();
    if (threadIdx.x == 0) {
        const unsigned x = xb_xcc_id();
        __builtin_amdgcn_s_waitcnt(0);
        unsigned nloc = st[0], nx = st[1];
        if (nloc == 0u) { xcd_barrier_complete(bar, x, nloc, nx); st[0] = nloc; st[1] = nx; }
        const unsigned old = xb_add(&bar[XB_XSUB(x)], 1u);
        const unsigned gen = old / nloc;
        if (old + 1u == (gen + 1u) * nloc) {
            __builtin_amdgcn_fence(__ATOMIC_RELEASE, "agent");
            asm volatile("s_waitcnt vmcnt(0)" ::: "memory");
            const unsigned og = xb_add(&bar[XB_TOP], 1u);
            const unsigned tg = og / nx;
            if (og + 1u == (tg + 1u) * nx) xb_add(&bar[XB_TOPGEN], 1u);
            else XB_SPIN(xb_ld(&bar[XB_TOPGEN]) == tg, bar);
            __builtin_amdgcn_fence(__ATOMIC_ACQUIRE, "agent");
            xb_add(&bar[XB_XGEN(x)], 1u);
            asm volatile("s_waitcnt vmcnt(0)" ::: "memory");
        } else {
            XB_SPIN(xb_ld(&bar[XB_XGEN(x)]) == gen, bar);
            __builtin_amdgcn_fence(__ATOMIC_ACQUIRE, "agent");
            asm volatile("s_waitcnt vmcnt(0)" ::: "memory");
        }
    }
    __syncthreads();
}
#ifndef PHMASK
#define PHMASK 0xffff
#endif
#ifndef PROBE
#define PROBE 0
#endif
__device__ __forceinline__ int opaque_i(int v) { asm volatile("" : "+s"(v)); return v; }
#define REP(n) for (int rep_ = 0, nrep_ = ((PROBE == (n)) ? opaque_i(2) : 1); rep_ < nrep_; ++rep_)
#define PH(n) ((PHMASK >> (n)) & 1)
struct Params { const float* in[29]; float* out; unsigned char* ws; };
enum { I_X = 0, I_P, I_F1N, I_F1IN, I_F1OUT, I_MIXN, I_WIN, I_MERGEB, I_CONVW, I_CONVB, I_RGWA, I_RGBA, I_RGWX, I_RGBX, I_RGLAM, I_FB, I_QN, I_KN,
       I_WRNN, I_WATT, I_WO, I_F2N, I_F2IN, I_F2OUT, I_PLEN, I_PLEWG, I_PLEBG, I_PLEWP, I_FINALN };

__device__ __forceinline__ float wave_sum(float v) {
#pragma unroll
    for (int o = 1; o < 64; o <<= 1) v += __shfl_xor(v, o);
    return v;
}
__device__ __forceinline__ void tr_item(const float* W, int ldw, int scol, const float* gain, float wscale, bf16_t* WT, int K, int drow, int k0, LAS float* scr, int lane) {
#pragma unroll
    for (int i = 0; i < 32; ++i) { const int kk = 2 * i + (lane >> 5); float v = W[(size_t)(k0 + kk) * ldw + scol + (lane & 31)]; if (gain) v *= gain[k0 + kk]; scr[kk * 33 + (lane & 31)] = v * wscale; }
    LDS_WAIT(); asm volatile("" ::: "memory");
    const int c = lane & 7;
#pragma unroll
    for (int j = 0; j < 4; ++j) { const int n = (lane >> 3) + 8 * j; const LAS float* s = scr + (8 * c) * 33 + n;
        u32x4 o; o.x = cvtpk(s[0 * 33], s[1 * 33]); o.y = cvtpk(s[2 * 33], s[3 * 33]); o.z = cvtpk(s[4 * 33], s[5 * 33]); o.w = cvtpk(s[6 * 33], s[7 * 33]);
        *(u32x4*)(WT + (size_t)(drow + n) * K + k0 + 8 * c) = o; }
    LDS_WAIT(); asm volatile("" ::: "memory");
}
__device__ __forceinline__ bool tr_seg(int& it, const float* W, int ldw, const float* gain, float wscale, bf16_t* WT, int K, int nrows, int mode, LAS float* scr, int lane) {
    const int nblk = nrows / 32, nit = (K / 64) * nblk;
    if (it >= nit) { it -= nit; return false; }
    const int kb = it / nblk, d0 = (it % nblk) * 32; int scol = d0;
    if (mode == 1) { const int t = d0 >> 8, r = d0 & 255; scol = (r >> 7) * FF + t * 128 + (r & 127); }
    else if (mode == 2) { scol = d0 < 5120 ? d0 : d0 + 8; }
    tr_item(W, ldw, scol, gain, wscale, WT, K, d0, kb * 64, scr, lane);
    return true;
}

#define GRID_SYNC() REP(3) do { xcd_barrier((unsigned*)(P.ws + WS_BAR), (volatile LAS unsigned*)(lds + LDS_BARST)); } while (0)
#define PHASE_IDS_ int tid = threadIdx.x; asm volatile("" : "+v"(tid)); const int lane = tid & 63, wave = __builtin_amdgcn_readfirstlane(tid >> 6), gw = vcu * 8 + wave, gt = bx * 512 + tid; (void)lane; (void)gw; (void)gt;
#define ssA ((float*)(ws + WS_SS0))
#define ssB ((float*)(ws + WS_SS1))
#define logf_ ((float*)(ws + WS_LOGF))
#define nd2 ((float*)(ws + WS_ND2))
#define agg ((float*)(ws + WS_AGG))
#define sp8 ((float*)(ws + WS_VEC))
#define wfg ((float*)(ws + WS_VEC) + 4096)
#define W1in_t ((bf16_t*)(ws + WS_W1IN))
#define W1out_t ((bf16_t*)(ws + WS_W1OUT))
#define Win_t ((bf16_t*)(ws + WS_WIN))
#define Wg_t ((bf16_t*)(ws + WS_WG))
#define Wr_t ((bf16_t*)(ws + WS_WR))
#define Wat_t ((bf16_t*)(ws + WS_WAT))
#define Wo_t ((bf16_t*)(ws + WS_WO))
#define W2in_t ((bf16_t*)(ws + WS_W2IN))
#define W2out_t ((bf16_t*)(ws + WS_W2OUT))
#define Wpg_t ((bf16_t*)(ws + WS_WPG))
#define Wpe_t ((bf16_t*)(ws + WS_WPE))
#define xb ((bf16_t*)(ws + WS_XB))
#define pb ((bf16_t*)(ws + WS_PB))
#define R ((bf16_t*)(ws + WS_R))
#define X1 ((bf16_t*)(ws + WS_X1))
#define act R
#define b_rx R
#define b_rgate (R + (size_t)T * DM)
#define b_q (R + 2 * (size_t)T * DM)
#define b_k (R + 3 * (size_t)T * DM)
#define b_v (R + 4 * (size_t)T * DM)
#define b_ga (R + 5 * (size_t)T * DM)
#define b_gb (R + 6 * (size_t)T * DM)
#define xb2 b_k
#define b_rxc xb
#define b_L b_rx
#define b_U X1
#define b_ya xb
#define b_mrg X1
#define b_E X1
#define xres (P.out + zz)
#define IN(i) (P.in[(i) + zz])
#define PHASE_PTRS int zz; asm volatile("s_mov_b32 %0, 0" : "=s"(zz)); unsigned char* ws = P.ws + zz; int G = G0, bx = bx0, vcu = vcu0; asm volatile("" : "+s"(G), "+s"(bx), "+s"(vcu)); const int NGW = G * 8, NGT = G * 512; (void)NGW; (void)NGT; (void)ws;


template <int l> __device__ __forceinline__ void layer_body(const Params& P, LAS unsigned char* lds, unsigned char* lds_raw, cg::grid_group& grid, const int G0, const int bx0, const int vcu0) {
    pg8::StaticOrder SO;
#if PH(0)
        REP(1) {
            PHASE_PTRS PHASE_IDS_
            LAS float* scr = (LAS float*)(lds + wave * 16384);
            const float* f1n = IN(I_F1N) + l * DM; const float* mixn = IN(I_MIXN) + l * DM; const float* f2n = IN(I_F2N) + l * DM; const float* plen = IN(I_PLEN) + l * DM;
            const float* f1in = IN(I_F1IN) + (size_t)l * DM * 2 * FF; const float* f1out = IN(I_F1OUT) + (size_t)l * FF * DM;
            const float* win = IN(I_WIN) + (size_t)l * DM * NIN;
            const float* wrnn = IN(I_WRNN) + (size_t)l * DM * DM; const float* watt = IN(I_WATT) + (size_t)l * DM * DM; const float* wo = IN(I_WO) + (size_t)l * DM * DM;
            const float* f2in = IN(I_F2IN) + (size_t)l * DM * 2 * FF; const float* f2out = IN(I_F2OUT) + (size_t)l * FF * DM;
            const float* plewg = IN(I_PLEWG) + (size_t)l * DM * DM; const float* plewp = IN(I_PLEWP) + (size_t)l * PLE * DM;
            constexpr int NIT = 16 * 176 + 44 * 32 + 16 * 224 + 3 * 16 * 32 + 16 * 176 + 44 * 32 + 16 * 32 + 4 * 32;
            for (int it0 = gw; it0 < NIT; it0 += NGW) {
                int it = it0;
                if (tr_seg(it, f1in, 2 * FF, f1n, 1.f, W1in_t, DM, 2 * FF, 1, scr, lane)) continue;
                if (tr_seg(it, f1out, DM, nullptr, 0.5f, W1out_t, FF, DM, 0, scr, lane)) continue;
                if (tr_seg(it, win, NIN, mixn, 1.f, Win_t, DM, 7 * DM, 2, scr, lane)) continue;
                if (tr_seg(it, wrnn, DM, nullptr, 1.f, Wr_t, DM, DM, 0, scr, lane)) continue;
                if (tr_seg(it, watt, DM, nullptr, 1.f, Wat_t, DM, DM, 0, scr, lane)) continue;
                if (tr_seg(it, wo, DM, nullptr, 1.f, Wo_t, DM, DM, 0, scr, lane)) continue;
                if (tr_seg(it, f2in, 2 * FF, f2n, 1.f, W2in_t, DM, 2 * FF, 1, scr, lane)) continue;
                if (tr_seg(it, f2out, DM, nullptr, 0.5f, W2out_t, FF, DM, 0, scr, lane)) continue;
                if (tr_seg(it, plewg, DM, plen, 1.f, Wpg_t, DM, DM, 0, scr, lane)) continue;
                tr_seg(it, plewp, DM, nullptr, 1.f, Wpe_t, PLE, DM, 0, scr, lane);
            }
            const float* rgwa = IN(I_RGWA) + (size_t)l * 16 * 64 * 64; const float* rgwx = IN(I_RGWX) + (size_t)l * 16 * 64 * 64;
            for (int e = gt; e < 2048 * 128; e += NGT) {
                const int Rr = e >> 7, kk = e & 127, pn = Rr >> 8, j = Rr & 255, c = 128 * pn + (j & 127), ic = 128 * pn + kk, blk = c >> 6;
                float v = 0.f; if ((ic >> 6) == blk) v = ((j >> 7) ? rgwx : rgwa)[((size_t)blk * 64 + (ic & 63)) * 64 + (c & 63)];
                Wg_t[e] = (bf16_t)(cvtpk(v, 0.f) & 0xffffu);
            }
            const float* lam = IN(I_RGLAM) + l * DM;
            for (int e = gt; e < DM; e += NGT) sp8[e] = 8.f * log1pf(expf(-lam[e]));
            for (int e = gt; e < DM * 8; e += NGT) { const int k = e >> 3, h = e & 7; wfg[e] = mixn[k] * win[(size_t)k * NIN + 5120 + h]; }
            const float* pl = IN(I_P) + (size_t)l * T * PLE;
            for (int e0 = gt; e0 < T * PLE / 8; e0 += 4 * NGT) { f32x4 pa[4], pq[4];
#pragma unroll
                for (int k = 0; k < 4; ++k) { const int e = e0 + k * NGT; if (e < T * PLE / 8) { pa[k] = *(const f32x4*)(pl + (size_t)e * 8); pq[k] = *(const f32x4*)(pl + (size_t)e * 8 + 4); } }
#pragma unroll
                for (int k = 0; k < 4; ++k) { const int e = e0 + k * NGT; if (e < T * PLE / 8) { u32x4 w; w.x = cvtpk(pa[k][0], pa[k][1]); w.y = cvtpk(pa[k][2], pa[k][3]); w.z = cvtpk(pq[k][0], pq[k][1]); w.w = cvtpk(pq[k][2], pq[k][3]); *(u32x4*)(pb + (size_t)e * 8) = w; } } }
            if (l == 0) {
                const float* x0 = IN(I_X);
                for (int row = gw; row < T; row += NGW) {
                    const f32x4* xr = (const f32x4*)(x0 + (size_t)row * DM) + lane; float s = 0.f;
                    u32x2* o8 = (u32x2*)(xb2 + (size_t)row * DM) + lane;
#pragma unroll
                    for (int j = 0; j < 4; ++j) { const f32x4 v = xr[64 * j]; s += (v[0] * v[0] + v[1] * v[1]) + (v[2] * v[2] + v[3] * v[3]); u32x2 w; w.x = cvtpk(v[0], v[1]); w.y = cvtpk(v[2], v[3]); o8[64 * j] = w; }
                    s = wave_sum(s);
                    if (lane < 16) ssA[(size_t)row * 16 + lane] = lane == 0 ? s : 0.f;
                }
            }
        }
#endif
        GRID_SYNC();
#if PH(1)
        REP(2) { PHASE_PTRS pg8::Gemm g{xb2, W1in_t, T, 2 * FF, DM, DM, 0}; SO.init(T, 2 * FF, G, bx); pg8::EpiSwiGLU E{act, ssA};
          pg8::gemm_phase<pg8::EpiSwiGLU, true>(lds, g, SO, E); }
#endif
        GRID_SYNC();
#if PH(2)
#if PROBE == 8
        { PHASE_PTRS const float* xin0 = (l == 0) ? IN(I_X) : xres; pg8::Gemm g{act, W1out_t, T, DM, FF, FF, 0}; SO.init(T, DM, G, bx);
          pg8::EpiResid<false> E{xin0, (float*)(R + 2 * (size_t)T * DM * 2), R + 6 * (size_t)T * DM, agg, nullptr, nullptr, nullptr};
          pg8::gemm_phase<pg8::EpiResid<false>, true>(lds, g, SO, E); }
#endif
        { PHASE_PTRS const float* xin0 = (l == 0) ? IN(I_X) : xres; pg8::Gemm g{act, W1out_t, T, DM, FF, FF, 0}; SO.init(T, DM, G, bx); pg8::EpiResid<false> E{xin0, xres, xb, ssB, nullptr, nullptr, nullptr};
          pg8::gemm_phase<pg8::EpiResid<false>, true>(lds, g, SO, E); }
#endif
        GRID_SYNC();
#if PH(3)
        REP(6) { PHASE_PTRS pg8::Gemm g{xb, Win_t, T, 7 * DM, DM, DM, 0}; SO.init(T, 7 * DM, G, bx); pg8::EpiProj E{R, ssB, IN(I_QN) + l * HD, IN(I_KN) + l * HD, (LAS float*)(lds + 131072)};
          pg8::gemm_phase<pg8::EpiProj, true>(lds, g, SO, E); }
        REP(1) {
            PHASE_PTRS PHASE_IDS_
            LAS float* wl = (LAS float*)lds;
            __syncthreads();
            for (int e = tid; e < DM * 8; e += 512) wl[e] = wfg[e];
            __syncthreads();
            const float* fb = IN(I_FB) + l * NH;
            f32x4 wr0[16], wr1[16];
#pragma unroll
            for (int j = 0; j < 4; ++j)
#pragma unroll
                for (int e = 0; e < 4; ++e) { const int k = 256 * j + 4 * lane + e; wr0[j * 4 + e] = *(const LAS f32x4*)(wl + k * 8); wr1[j * 4 + e] = *(const LAS f32x4*)(wl + k * 8 + 4); }
            f32x4 xv[4];
            if (gw < T) { const f32x4* xr0 = (const f32x4*)(xres + (size_t)gw * DM) + lane;
#pragma unroll
                for (int j = 0; j < 4; ++j) xv[j] = xr0[64 * j]; }
            for (int row = gw; row < T; row += NGW) {
                float s = 0.f; float a8[8] = {0.f, 0.f, 0.f, 0.f, 0.f, 0.f, 0.f, 0.f};
                f32x4 xc4[4];
#pragma unroll
                for (int j = 0; j < 4; ++j) xc4[j] = xv[j];
                if (row + NGW < T) { const f32x4* xrn = (const f32x4*)(xres + (size_t)(row + NGW) * DM) + lane;
#pragma unroll
                    for (int j = 0; j < 4; ++j) xv[j] = xrn[64 * j]; }
#pragma unroll
                for (int j = 0; j < 4; ++j) { const f32x4 v = xc4[j]; s += (v[0] * v[0] + v[1] * v[1]) + (v[2] * v[2] + v[3] * v[3]);
#pragma unroll
                    for (int e = 0; e < 4; ++e) { const f32x4 w0 = wr0[j * 4 + e], w1 = wr1[j * 4 + e];
                        a8[0] += v[e] * w0[0]; a8[1] += v[e] * w0[1]; a8[2] += v[e] * w0[2]; a8[3] += v[e] * w0[3]; a8[4] += v[e] * w1[0]; a8[5] += v[e] * w1[1]; a8[6] += v[e] * w1[2]; a8[7] += v[e] * w1[3]; } }
                s = wave_sum(s); const float r = rsqrtf(s * (1.f / DM) + EPS);
                float b4[4], c2[2], mine;
                { const bool up = lane & 1;
#pragma unroll
                  for (int i = 0; i < 4; ++i) { const float snd = up ? a8[i] : a8[4 + i], kp = up ? a8[4 + i] : a8[i]; b4[i] = kp + __shfl_xor(snd, 1); } }
                { const bool up = lane & 2;
#pragma unroll
                  for (int i = 0; i < 2; ++i) { const float snd = up ? b4[i] : b4[2 + i], kp = up ? b4[2 + i] : b4[i]; c2[i] = kp + __shfl_xor(snd, 2); } }
                { const bool up = lane & 4; const float snd = up ? c2[0] : c2[1], kp = up ? c2[1] : c2[0]; mine = kp + __shfl_xor(snd, 4); }
                mine += __shfl_xor(mine, 8); mine += __shfl_xor(mine, 16); mine += __shfl_xor(mine, 32);
                if (lane < 8) { const int hh = ((lane & 1) << 2) | (lane & 2) | ((lane >> 2) & 1);
                    const float z = mine * r + fb[hh]; const float lf = (z >= 0.f) ? -log1pf(expf(-z)) : z - log1pf(expf(z));
                    const int b = row / SEQ, t = row % SEQ; logf_[((size_t)(b * NH + hh)) * SEQ + t] = lf; }
            }
        }
#endif
        GRID_SYNC();
#if PH(4)
        {
            PHASE_PTRS PHASE_IDS_
            const float* cw = IN(I_CONVW) + (size_t)l * 4 * DM; const float* cb = IN(I_CONVB) + l * DM;
            REP(1) for (int task = gt; task < (T / 16) * 128; task += NGT) {
                const int cgp = task & 127, run = task >> 7, c0 = cgp * 8, t0 = run * 16;
                float w[4][8], bb[8];
#pragma unroll
                for (int k = 0; k < 4; ++k) { const f32x4 a = *(const f32x4*)(cw + k * DM + c0), b = *(const f32x4*)(cw + k * DM + c0 + 4);
                    w[k][0] = a[0]; w[k][1] = a[1]; w[k][2] = a[2]; w[k][3] = a[3]; w[k][4] = b[0]; w[k][5] = b[1]; w[k][6] = b[2]; w[k][7] = b[3]; }
                { const f32x4 a = *(const f32x4*)(cb + c0), b = *(const f32x4*)(cb + c0 + 4); bb[0] = a[0]; bb[1] = a[1]; bb[2] = a[2]; bb[3] = a[3]; bb[4] = b[0]; bb[5] = b[1]; bb[6] = b[2]; bb[7] = b[3]; }
                float h0[8], h1[8], h2[8];
                const bool first = (t0 % SEQ) == 0;
                u32x4 z = {0u, 0u, 0u, 0u};
                u32x4 r0 = first ? z : *(const u32x4*)(b_rx + (size_t)(t0 - 3) * DM + c0), r1 = first ? z : *(const u32x4*)(b_rx + (size_t)(t0 - 2) * DM + c0), r2 = first ? z : *(const u32x4*)(b_rx + (size_t)(t0 - 1) * DM + c0);
#define UNP(dst, rr) do { dst[0] = bflo(rr.x); dst[1] = bfhi(rr.x); dst[2] = bflo(rr.y); dst[3] = bfhi(rr.y); dst[4] = bflo(rr.z); dst[5] = bfhi(rr.z); dst[6] = bflo(rr.w); dst[7] = bfhi(rr.w); } while (0)
                UNP(h0, r0); UNP(h1, r1); UNP(h2, r2);
#pragma unroll
                for (int i = 0; i < 16; ++i) {
                    const u32x4 rc = *(const u32x4*)(b_rx + (size_t)(t0 + i) * DM + c0); float h3[8]; UNP(h3, rc); float y[8];
#pragma unroll
                    for (int j = 0; j < 8; ++j) { y[j] = bb[j] + w[0][j] * h0[j] + w[1][j] * h1[j] + w[2][j] * h2[j] + w[3][j] * h3[j]; h0[j] = h1[j]; h1[j] = h2[j]; h2[j] = h3[j]; }
                    u32x4 o; o.x = cvtpk(y[0], y[1]); o.y = cvtpk(y[2], y[3]); o.z = cvtpk(y[4], y[5]); o.w = cvtpk(y[6], y[7]);
                    *(u32x4*)(b_rxc + (size_t)(t0 + i) * DM + c0) = o;
                }
            }
#undef UNP
            if (gt == 0) *(unsigned*)(ws + WS_VEC + 262144) = 0u;
            if (vcu < NB * NH) {
                LAS float* wsum = (LAS float*)lds;
                const float* src = logf_ + (size_t)vcu * SEQ + tid * 16; float v[16];
#pragma unroll
                for (int j = 0; j < 4; ++j) { const f32x4 a = *(const f32x4*)(src + 4 * j); v[4 * j] = a[0]; v[4 * j + 1] = a[1]; v[4 * j + 2] = a[2]; v[4 * j + 3] = a[3]; }
#pragma unroll
                for (int j = 1; j < 16; ++j) v[j] += v[j - 1];
                float incl = v[15];
#pragma unroll
                for (int o = 1; o < 64; o <<= 1) { const float n = __shfl_up(incl, o); if (lane >= o) incl += n; }
                __syncthreads();
                if (lane == 63) wsum[wave] = incl;
                __syncthreads();
                float basev = incl - v[15];
                for (int w = 0; w < wave; ++w) basev += wsum[w];
                float* dst = nd2 + (size_t)vcu * SEQ + tid * 16;
#pragma unroll
                for (int j = 0; j < 4; ++j) { f32x4 o; o[0] = -LOG2E * (basev + v[4 * j]); o[1] = -LOG2E * (basev + v[4 * j + 1]); o[2] = -LOG2E * (basev + v[4 * j + 2]); o[3] = -LOG2E * (basev + v[4 * j + 3]); *(f32x4*)(dst + 4 * j) = o; }
                __syncthreads();
            }
        }
#endif
        GRID_SYNC();
#if PH(5)
        REP(5) { PHASE_PTRS pg8::Gemm g{b_rxc, Wg_t, T, 2 * DM, 128, DM, 128}; SO.init(T, 2 * DM, G, bx);
          pg8::EpiGate E{b_rxc, b_L, b_U, IN(I_RGBA) + l * DM, IN(I_RGBX) + l * DM, sp8};
          pg8::gemm_phase<pg8::EpiGate, true>(lds, g, SO, E); }
#endif
#if PH(13)
        { PHASE_PTRS __syncthreads();
        att::attn_phase((char*)lds_raw, (const att::bf16*)b_q, (const att::bf16*)b_k, (const att::bf16*)b_v, (att::bf16*)b_q, nd2, (unsigned*)(ws + WS_VEC + 262144), IN(I_QN) + l * HD, IN(I_KN) + l * HD); }
#endif
        GRID_SYNC();
#if PH(6)
        REP(1) { PHASE_PTRS PHASE_IDS_
        for (int task = gt; task < NB * 64 * 512; task += NGT) {
            const int cp = task & 511, ch = (task >> 9) & 63, b = task >> 15; const size_t base = ((size_t)b * SEQ + (size_t)ch * 128) * DM + cp * 2;
            float A0 = 1.f, A1 = 1.f, H0 = 0.f, H1 = 0.f;
#pragma unroll 16
            for (int i = 0; i < 128; ++i) { const unsigned lw = *(const unsigned*)(b_L + base + (size_t)i * DM), uw = *(const unsigned*)(b_U + base + (size_t)i * DM);
                const float a0 = __builtin_amdgcn_exp2f(bflo(lw) * LOG2E), a1 = __builtin_amdgcn_exp2f(bfhi(lw) * LOG2E);
                A0 *= a0; A1 *= a1; H0 = a0 * H0 + bflo(uw); H1 = a1 * H1 + bfhi(uw); }
            f32x4 o = {A0, H0, A1, H1}; *(f32x4*)(agg + ((size_t)(b * 64 + ch) * DM + cp * 2) * 2) = o;
        } }
#endif
        GRID_SYNC();
#if PH(7)
        REP(1) { PHASE_PTRS PHASE_IDS_
        for (int task = gt; task < NB * 64 * 512; task += NGT) {
            const int cp = task & 511, ch = (task >> 9) & 63, b = task >> 15; const size_t base = ((size_t)b * SEQ + (size_t)ch * 128) * DM + cp * 2;
            float H0 = 0.f, H1 = 0.f;
            for (int j = 0; j < ch; j += 8) {
                f32x4 ag[8];
#pragma unroll
                for (int k = 0; k < 8; ++k) { const int jj = (j + k < ch) ? j + k : j; ag[k] = *(const f32x4*)(agg + ((size_t)(b * 64 + jj) * DM + cp * 2) * 2); }
#pragma unroll
                for (int k = 0; k < 8; ++k) if (j + k < ch) { H0 = ag[k][0] * H0 + ag[k][1]; H1 = ag[k][2] * H1 + ag[k][3]; }
            }
            for (int i0 = 0; i0 < 128; i0 += 16) {
                unsigned lw[16], uw[16], gv[16];
#pragma unroll
                for (int k = 0; k < 16; ++k) { const size_t off = base + (size_t)(i0 + k) * DM; lw[k] = *(const unsigned*)(b_L + off); uw[k] = *(const unsigned*)(b_U + off); gv[k] = *(const unsigned*)(b_rgate + off); }
#pragma unroll
                for (int k = 0; k < 16; ++k) { const size_t off = base + (size_t)(i0 + k) * DM;
                    const float a0 = __builtin_amdgcn_exp2f(bflo(lw[k]) * LOG2E), a1 = __builtin_amdgcn_exp2f(bfhi(lw[k]) * LOG2E);
                    H0 = a0 * H0 + bflo(uw[k]); H1 = a1 * H1 + bfhi(uw[k]);
                    *(unsigned*)(b_ya + off) = cvtpk(H0 * gelu_tanh(bflo(gv[k])), H1 * gelu_tanh(bfhi(gv[k]))); }
            }
        } }
#endif
        GRID_SYNC();
#if PH(8)
        REP(4) {
          { PHASE_PTRS const float* mb = IN(I_MERGEB) + l * 2 * DM; pg8::Gemm g{b_ya, Wr_t, T, DM, DM, DM, 0}; SO.init(T, DM, G, bx); pg8::EpiMerge<false> E{b_ga, mb, nullptr, b_mrg};
            pg8::gemm_phase<pg8::EpiMerge<false>, true>(lds, g, SO, E); }
          { PHASE_PTRS const float* mb = IN(I_MERGEB) + l * 2 * DM; pg8::Gemm g{b_q, Wat_t, T, DM, DM, DM, 0}; SO.init(T, DM, G, bx); pg8::EpiMerge<true> E{b_gb, mb + DM, b_mrg, b_mrg};
            pg8::gemm_phase<pg8::EpiMerge<true>, true>(lds, g, SO, E); } }
#endif
        GRID_SYNC();
#if PH(9)
        { PHASE_PTRS pg8::Gemm g{b_mrg, Wo_t, T, DM, DM, DM, 0}; SO.init(T, DM, G, bx); pg8::EpiResid<false> E{xres, xres, xb, ssA, nullptr, nullptr, nullptr};
          pg8::gemm_phase<pg8::EpiResid<false>, true>(lds, g, SO, E); }
#endif
        GRID_SYNC();
#if PH(10)
        { PHASE_PTRS pg8::Gemm g{xb, W2in_t, T, 2 * FF, DM, DM, 0}; SO.init(T, 2 * FF, G, bx); pg8::EpiSwiGLU E{act, ssA};
          pg8::gemm_phase<pg8::EpiSwiGLU, true>(lds, g, SO, E); }
        { PHASE_PTRS pg8::Gemm g{pb, Wpe_t, T, DM, PLE, PLE, 0}; SO.init(T, DM, G, bx); pg8::EpiPlain E{b_E};
          pg8::gemm_phase<pg8::EpiPlain, true>(lds, g, SO, E); }
#endif
        GRID_SYNC();
#if PH(11)
        { PHASE_PTRS pg8::Gemm g{act, W2out_t, T, DM, FF, FF, 0}; SO.init(T, DM, G, bx); pg8::EpiResid<false> E{xres, xres, xb, ssB, nullptr, nullptr, nullptr};
          pg8::gemm_phase<pg8::EpiResid<false>, true>(lds, g, SO, E); }
#endif
        GRID_SYNC();
#if PH(12)
        { PHASE_PTRS pg8::Gemm g{xb, Wpg_t, T, DM, DM, DM, 0}; SO.init(T, DM, G, bx); pg8::EpiResid<true> E{xres, xres, xb2, ssA, ssB, IN(I_PLEBG) + l * DM, b_E};
          pg8::gemm_phase<pg8::EpiResid<true>, true>(lds, g, SO, E); }
#endif
        GRID_SYNC();
}

__global__ void __launch_bounds__(512, 2) fwd_kernel(Params P) {
    extern __shared__ __attribute__((aligned(16))) unsigned char lds_raw[];
    LAS unsigned char* lds = (LAS unsigned char*)lds_raw;
    cg::grid_group grid = cg::this_grid();
    const int G0 = gridDim.x, bx0 = blockIdx.x;
    const int vcu0 = (G0 % 8 == 0) ? (bx0 % 8) * (G0 / 8) + bx0 / 8 : bx0;
    if (threadIdx.x < 2) ((volatile LAS unsigned*)(lds + LDS_BARST))[threadIdx.x] = 0u;
    if (threadIdx.x == 0) (void)xb_add((unsigned*)(P.ws + WS_BAR) + XB_XCNT(xb_xcc_id()), 1u);
    __syncthreads();
    if (P.ws == nullptr) grid.sync();
    layer_body<0>(P, lds, lds_raw, grid, G0, bx0, vcu0);
    layer_body<1>(P, lds, lds_raw, grid, G0, bx0, vcu0);
    layer_body<2>(P, lds, lds_raw, grid, G0, bx0, vcu0);
    layer_body<3>(P, lds, lds_raw, grid, G0, bx0, vcu0);
    {
        PHASE_PTRS PHASE_IDS_
        const float* gf = IN(I_FINALN);
        f32x4 nv[4];
        if (gw < T) { const f32x4* xr0 = (const f32x4*)(xres + (size_t)gw * DM) + lane;
#pragma unroll
            for (int j = 0; j < 4; ++j) nv[j] = xr0[64 * j]; }
        for (int row = gw; row < T; row += NGW) {
            f32x4* xr = (f32x4*)(xres + (size_t)row * DM) + lane; f32x4 v[4]; float s = 0.f;
#pragma unroll
            for (int j = 0; j < 4; ++j) v[j] = nv[j];
            if (row + NGW < T) { const f32x4* xrn = (const f32x4*)(xres + (size_t)(row + NGW) * DM) + lane;
#pragma unroll
                for (int j = 0; j < 4; ++j) nv[j] = xrn[64 * j]; }
#pragma unroll
            for (int j = 0; j < 4; ++j) { s += (v[j][0] * v[j][0] + v[j][1] * v[j][1]) + (v[j][2] * v[j][2] + v[j][3] * v[j][3]); }
            s = wave_sum(s); const float r = rsqrtf(s * (1.f / DM) + EPS);
#pragma unroll
            for (int j = 0; j < 4; ++j) { const f32x4 gv = *((const f32x4*)gf + lane + 64 * j); xr[64 * j] = v[j] * r * gv; }
        }
    }
}

extern "C" void kernel_launch(void* const* d_in, const int* in_sizes, int n_in, void* d_out, int out_size, void* d_ws, size_t ws_size, hipStream_t stream) {
    static int grid = 0;
    if (grid == 0) {
        if (n_in != 29 || out_size != T * DM || ws_size < WS_END) { fprintf(stderr, "kernel_launch: unexpected problem (n_in %d out %d ws %zu)\n", n_in, out_size, ws_size); grid = -1; return; }
        int dev = 0, cus = 0, per_cu = 0;
        (void)hipGetDevice(&dev); (void)hipDeviceGetAttribute(&cus, hipDeviceAttributeMultiprocessorCount, dev);
        (void)hipFuncSetAttribute((const void*)fwd_kernel, hipFuncAttributeMaxDynamicSharedMemorySize, LDS_BYTES);
        (void)hipOccupancyMaxActiveBlocksPerMultiprocessor(&per_cu, (const void*)fwd_kernel, 512, LDS_BYTES);
        if (cus <= 0) cus = 256;
        grid = cus;
        if (per_cu < 1) fprintf(stderr, "kernel_launch: occupancy query reports %d workgroups per CU\n", per_cu);
        (void)hipGetLastError();
    }
    if (grid < 0) return;
    if (hipMemsetAsync((char*)d_ws + WS_BAR, 0, XCD_BAR_WORDS * 4, stream) != hipSuccess) { fprintf(stderr, "kernel_launch: memset failed\n"); return; }
    Params p{};
    for (int i = 0; i < 29; ++i) p.in[i] = (const float*)d_in[i];
    p.out = (float*)d_out; p.ws = (unsigned char*)d_ws;
    void* args[] = {&p};
    hipError_t e = hipLaunchCooperativeKernel((const void*)fwd_kernel, dim3(grid), dim3(512), args, LDS_BYTES, stream);
    if (e != hipSuccess) fprintf(stderr, "cooperative launch failed: %s (grid %d)\n", hipGetErrorString(e), grid);
}
```

```cpp
#include <hip/hip_runtime.h>
#include <hip/hip_cooperative_groups.h>
#include <hip/hip_bf16.h>
#include <cstdio>
#include <cstdint>
namespace cg = cooperative_groups;

#ifndef PROBE
#define PROBE 0
#endif
#define LAS __attribute__((address_space(3)))
typedef unsigned short bf16_t;
typedef short bf16x8 __attribute__((ext_vector_type(8)));
typedef short s16x4 __attribute__((ext_vector_type(4)));
typedef float f32x4 __attribute__((ext_vector_type(4)));
typedef float f32x16 __attribute__((ext_vector_type(16)));
typedef unsigned u32x4 __attribute__((ext_vector_type(4)));
typedef unsigned u32x2 __attribute__((ext_vector_type(2)));

constexpr int NB = 4, SEQ = 8192, T = NB * SEQ, DM = 1024, FF = 2816, NH = 8, HD = 128, NL = 4, PLE = 256, NIN = 7176;
constexpr float EPS = 1e-6f;
constexpr float LOG2E = 1.4426950408889634f;

constexpr size_t MiB = 1u << 20;
constexpr size_t WS_SS0 = 0, WS_SS1 = 2 * MiB, WS_LOGF = 4 * MiB, WS_ND2 = 5 * MiB, WS_AGG = 6 * MiB, WS_VEC = 8 * MiB;
constexpr size_t WS_W1IN = 16 * MiB, WS_W1OUT = 27 * MiB, WS_WIN = 33 * MiB, WS_WG = 47 * MiB, WS_WR = 48 * MiB, WS_WAT = 50 * MiB, WS_WO = 52 * MiB,
                 WS_W2IN = 54 * MiB, WS_W2OUT = 65 * MiB, WS_WPG = 71 * MiB, WS_WPE = 73 * MiB;
constexpr size_t WS_XB = 80 * MiB, WS_PB = 144 * MiB, WS_R = 160 * MiB, WS_X1 = 608 * MiB, WS_END = 672 * MiB;
constexpr size_t BUF = 64 * MiB;
constexpr int LDS_BYTES = 147456;

__device__ __forceinline__ unsigned cvtpk(float lo, float hi) { unsigned r; asm volatile("v_cvt_pk_bf16_f32 %0, %1, %2" : "=v"(r) : "v"(lo), "v"(hi)); return r; }
__device__ __forceinline__ float bflo(unsigned u) { return __uint_as_float(u << 16); }
__device__ __forceinline__ float bfhi(unsigned u) { return __uint_as_float(u & 0xffff0000u); }
__device__ __forceinline__ float sigmoidf_(float x) { return __builtin_amdgcn_rcpf(1.f + __builtin_amdgcn_exp2f(-x * LOG2E)); }
__device__ __forceinline__ float gelu_tanh(float x) { const float u2 = 1.5957691216f * (x + 0.044715f * x * x * x); return x * sigmoidf_(u2); }
__device__ __forceinline__ float row_rstd(const float* ss, int row) {
    const f32x4* p = (const f32x4*)(ss + (size_t)row * 16);
    const f32x4 a = p[0], b = p[1], c = p[2], d = p[3];
    const float s = ((a[0] + a[1]) + (a[2] + a[3])) + ((b[0] + b[1]) + (b[2] + b[3])) + ((c[0] + c[1]) + (c[2] + c[3])) + ((d[0] + d[1]) + (d[2] + d[3]));
    return rsqrtf(s * (1.f / 1024.f) + EPS);
}
#define LDS_WAIT() asm volatile("s_waitcnt lgkmcnt(0)" ::: "memory")

namespace pg8 {
constexpr int BM = 256, BK = 64, HALF = 128, HTB = HALF * BK * 2, STAGE_BYTES = 8 * HTB, NXCD = 8, WGM = 8;
__host__ __device__ __forceinline__ int lds_byte(int r, int c) { const int st = (r >> 4) * 2 + (c >> 5), rr = r & 15, cc = c & 31, ob = rr * 64 + cc * 2; return st * 1024 + (ob ^ (((ob >> 9) & 1) << 5)); }
__host__ __device__ __forceinline__ void stage_rc(int b, int& R, int& C) { const int st = b / 1024, sb = b % 1024, swz = sb ^ (((sb >> 9) & 1) << 5); R = (st >> 1) * 16 + swz / 64; C = (st & 1) * 32 + (swz % 64) / 2; }
__host__ __device__ __forceinline__ int perm32(int rho) { const int n = rho >> 4, i = rho & 15; return 8 * (i >> 2) + 4 * n + (i & 3); }
struct Unit { int pm, pn; };
struct Gemm { const bf16_t* A; const bf16_t* Bt; int M, N, K; int lda; int a_pn_off; };
struct StaticOrder {
    int nM, nN, nwg, G, c;
    __device__ void init(int M, int N, int G_, int c_) { nM = M / BM; nN = N / BM; nwg = nM * nN; G = G_; c = c_; }
    __device__ bool next(int i, Unit& u) const {
        const long L = (long)i * G + c; if (L >= nwg) return false;
        int wgid = (int)L; { const int q = nwg / NXCD, r = nwg % NXCD, xcd = wgid % NXCD, off = wgid / NXCD; wgid = (xcd < r ? xcd * (q + 1) : r * (q + 1) + (xcd - r) * q) + off; }
        const int nig = WGM * nN, gid = wgid / nig, fm = gid * WGM, gsz = (nM - fm) < WGM ? (nM - fm) : WGM;
        u.pm = fm + ((wgid % nig) % gsz); u.pn = (wgid % nig) / gsz; return true;
    }
};

constexpr int RSTD_TBL_OFF = 131072 + 8192;
__device__ __forceinline__ void rstd_prep(const float* ss, int pm, int& prev_pm, int& tb, LAS float* tbl, int tid) {
    if (pm == prev_pm) return;
    tb ^= 1; prev_pm = pm;
    if (tid < 256) tbl[tb * 256 + tid] = row_rstd(ss, pm * 256 + tid);
}
typedef f32x4 Acc[2][2][4][2];
__device__ __forceinline__ void zero_acc(Acc& acc) {
#pragma unroll
    for (int a = 0; a < 2; ++a)
#pragma unroll
        for (int b = 0; b < 2; ++b)
#pragma unroll
            for (int m = 0; m < 4; ++m)
#pragma unroll
                for (int n = 0; n < 2; ++n) acc[a][b][m][n] = (f32x4){0.f, 0.f, 0.f, 0.f};
}
template <class Epi, bool ALIGN_EPI>
__device__ __forceinline__ void gemm_phase(LAS unsigned char* lds, const Gemm g, const StaticOrder& S, const Epi& E) {
    int tid = threadIdx.x; asm volatile("" : "+v"(tid));
    const int wid = __builtin_amdgcn_readfirstlane(tid >> 6), lane = tid & 63, wr = wid >> 2, wc = wid & 3, fr = lane & 15, fq = lane >> 4;
    const int K = g.K, nt = K / BK;
    unsigned voffA[2], voffB[2];
#pragma unroll
    for (int i = 0; i < 2; ++i) { int R, C; stage_rc(tid * 16 + i * 8192, R, C); const int Rb = Epi::PERM ? ((R & ~31) + perm32(R & 31)) : R;
        voffA[i] = (unsigned)(R * g.lda + C) * 2u; voffB[i] = (unsigned)(Rb * K + C) * 2u; }
    const size_t kstep = (size_t)(BK * 2);
    const size_t hstepA = (size_t)HALF * g.lda * 2, hstepB = (size_t)HALF * K * 2;
    const size_t tstepA = 2 * hstepA, tstepB = 2 * hstepB;
    const size_t pnoffA = (size_t)g.a_pn_off * 2;
    const unsigned ldsw = (unsigned)wid * 1024u;
    const int aoff = lds_byte(wr * 64 + fr, fq * 8), boff = lds_byte(wc * 32 + fr, fq * 8);
#define PG8_SA(b, h) (((b) * 2 + (h)) * HTB)
#define PG8_SB(b, h) ((4 + (b) * 2 + (h)) * HTB)
#define PG8_STAGE(bufoff, gbase, voff) do { _Pragma("unroll") for (int _i = 0; _i < 2; ++_i) \
        __builtin_amdgcn_global_load_lds((const unsigned*)((const char*)(gbase) + (voff)[_i]), (LAS unsigned*)(lds + (bufoff) + ldsw + _i * 8192), 16, 0, 0); } while (0)
#define PG8_LDA(dst, b, h) do { _Pragma("unroll") for (int m = 0; m < 4; ++m) _Pragma("unroll") for (int k = 0; k < 2; ++k) dst[m][k] = *(const LAS bf16x8*)(lds + PG8_SA(b, h) + aoff + m * 2048 + k * 1024); } while (0)
#define PG8_LDB(dst, b, h) do { _Pragma("unroll") for (int n = 0; n < 2; ++n) _Pragma("unroll") for (int k = 0; k < 2; ++k) dst[n][k] = *(const LAS bf16x8*)(lds + PG8_SB(b, h) + boff + n * 2048 + k * 1024); } while (0)
#define PG8_MMA(ai, bj, At, Bt) do { __builtin_amdgcn_s_setprio(1); _Pragma("unroll") for (int m = 0; m < 4; ++m) _Pragma("unroll") for (int n = 0; n < 2; ++n) _Pragma("unroll") for (int k = 0; k < 2; ++k) \
        acc[ai][bj][m][n] = __builtin_amdgcn_mfma_f32_16x16x32_bf16(Bt[n][k], At[m][k], acc[ai][bj][m][n], 0, 0, 0); __builtin_amdgcn_s_setprio(0); } while (0)
#define PG8_WAIT_V(n) asm volatile("s_waitcnt vmcnt(" #n ")" ::: "memory")
#define PG8_WAIT_L(n) asm volatile("s_waitcnt lgkmcnt(" #n ")" ::: "memory")
#define PG8_BAR __builtin_amdgcn_s_barrier()
#define PG8_SCHED __builtin_amdgcn_sched_barrier(0)
    Unit cur, nxt; int ui = 0;
    if (!S.next(0, cur)) return;
    f32x4 acc[2][2][4][2];
    E.init(acc, cur, wr, wc, fr, fq);
    int prev_pm = -1, tb = 0;
    E.prep(cur.pm, prev_pm, tb, (LAS float*)(lds + RSTD_TBL_OFF), tid);
    bf16x8 At[4][2], B0[2][2], B1[2][2];
    const char* cA = (const char*)g.A + (size_t)cur.pm * tstepA + (size_t)cur.pn * pnoffA; const char* cB = (const char*)g.Bt + (size_t)cur.pn * tstepB;
    PG8_STAGE(PG8_SB(0, 0), cB, voffB); PG8_STAGE(PG8_SB(0, 1), cB + hstepB, voffB); PG8_STAGE(PG8_SA(0, 0), cA, voffA); PG8_STAGE(PG8_SA(0, 1), cA + hstepA, voffA);
    if (wr == 1) PG8_BAR;
    PG8_WAIT_V(2); PG8_BAR;
    PG8_STAGE(PG8_SB(1, 0), cB + kstep, voffB); PG8_STAGE(PG8_SA(1, 0), cA + kstep, voffA); PG8_STAGE(PG8_SB(1, 1), cB + hstepB + kstep, voffB);
    PG8_WAIT_V(6); PG8_BAR;
    for (;;) {
        const bool has_next = S.next(ui + 1, nxt);
        const char* nA = has_next ? (const char*)g.A + (size_t)nxt.pm * tstepA + (size_t)nxt.pn * pnoffA : cA; const char* nB = has_next ? (const char*)g.Bt + (size_t)nxt.pn * tstepB : cB;
        for (int t = 0; t < nt; t += 2) {
            const bool last = (t == nt - 2);
            const char* a1 = cA + (size_t)(t + 1) * kstep;
            const char* a2 = last ? nA : cA + (size_t)(t + 2) * kstep; const char* b2 = last ? nB : cB + (size_t)(t + 2) * kstep;
            const char* a3 = a2 + kstep; const char* b3 = b2 + kstep;
            PG8_LDB(B0, 0, 0); PG8_LDB(B1, 0, 1); PG8_SCHED; PG8_LDA(At, 0, 0); PG8_STAGE(PG8_SA(1, 1), a1 + hstepA, voffA);
            PG8_WAIT_V(8); PG8_WAIT_L(0); PG8_BAR; PG8_MMA(0, 0, At, B0); PG8_MMA(0, 1, At, B1); PG8_BAR; PG8_SCHED;
            PG8_LDA(At, 0, 1); PG8_STAGE(PG8_SB(0, 0), b2, voffB); PG8_STAGE(PG8_SB(0, 1), b2 + hstepB, voffB); PG8_STAGE(PG8_SA(0, 0), a2, voffA);
            PG8_WAIT_V(8); PG8_WAIT_L(0); PG8_BAR; PG8_MMA(1, 0, At, B0); PG8_MMA(1, 1, At, B1); PG8_BAR; PG8_SCHED;
            PG8_LDB(B0, 1, 0); PG8_LDB(B1, 1, 1); PG8_SCHED; PG8_LDA(At, 1, 0); PG8_STAGE(PG8_SA(0, 1), a2 + hstepA, voffA);
            PG8_WAIT_V(8); PG8_WAIT_L(0); PG8_BAR; PG8_MMA(0, 0, At, B0); PG8_MMA(0, 1, At, B1); PG8_BAR; PG8_SCHED;
            PG8_LDA(At, 1, 1); PG8_STAGE(PG8_SB(1, 0), b3, voffB); PG8_STAGE(PG8_SB(1, 1), b3 + hstepB, voffB); PG8_STAGE(PG8_SA(1, 0), a3, voffA);
            PG8_WAIT_V(8); PG8_WAIT_L(0); PG8_BAR; PG8_MMA(1, 0, At, B0); PG8_MMA(1, 1, At, B1); PG8_BAR; PG8_SCHED;
        }
        if constexpr (ALIGN_EPI) { if (wr == 0) PG8_BAR; }
        E(acc, cur, wr, wc, fr, fq, (const LAS float*)(lds + RSTD_TBL_OFF) + tb * 256);
        if (!has_next) break;
        E.init(acc, nxt, wr, wc, fr, fq);
        E.prep(nxt.pm, prev_pm, tb, (LAS float*)(lds + RSTD_TBL_OFF), tid);
        cur = nxt; cA = nA; cB = nB; ++ui;
        if constexpr (ALIGN_EPI) { if (wr == 1) PG8_BAR; }
    }
    PG8_WAIT_V(0);
    if constexpr (!ALIGN_EPI) { if (wr == 0) PG8_BAR; }
    PG8_BAR;
#undef PG8_SA
#undef PG8_SB
#undef PG8_STAGE
#undef PG8_LDA
#undef PG8_LDB
#undef PG8_MMA
#undef PG8_WAIT_V
#undef PG8_WAIT_L
#undef PG8_BAR
#undef PG8_SCHED
}


struct EpiSwiGLU {
    static constexpr bool PERM = true;
    __device__ __forceinline__ void init(Acc& acc, const Unit&, int, int, int, int) const { zero_acc(acc); }
    __device__ __forceinline__ void prep(int pm, int& prev_pm, int& tb, LAS float* tbl, int tid) const { rstd_prep(ss, pm, prev_pm, tb, tbl, tid); }
    bf16_t* O; const float* ss;
    __device__ __forceinline__ void operator()(const Acc& acc, const Unit& u, int wr, int wc, int fr, int fq, const LAS float* rt) const {
        const int row0 = u.pm * BM + wr * 64 + fr, col0 = u.pn * 128 + wc * 32 + 8 * fq;
#pragma unroll
        for (int ai = 0; ai < 2; ++ai)
#pragma unroll
            for (int m = 0; m < 4; ++m) {
                const int row = row0 + ai * HALF + m * 16; const float r = rt[ai * HALF + wr * 64 + m * 16 + fr];
                float h[8];
#pragma unroll
                for (int n = 0; n < 2; ++n)
#pragma unroll
                    for (int e = 0; e < 4; ++e) { const float gg = acc[ai][0][m][n][e] * r, uu = acc[ai][1][m][n][e] * r; h[n * 4 + e] = gg * sigmoidf_(gg) * uu; }
                u32x4 w; w.x = cvtpk(h[0], h[1]); w.y = cvtpk(h[2], h[3]); w.z = cvtpk(h[4], h[5]); w.w = cvtpk(h[6], h[7]);
                __builtin_nontemporal_store(w, (u32x4*)(O + (size_t)row * FF + col0));
            }
    }
};
template <bool GATE> struct EpiResid {
    static constexpr bool PERM = false;
    const float* xin; float* xout; bf16_t* xb; float* ss_out; const float* ss_in; const float* bias; const bf16_t* Eb;
    __device__ __forceinline__ void prep(int pm, int& prev_pm, int& tb, LAS float* tbl, int tid) const { if (GATE) rstd_prep(ss_in, pm, prev_pm, tb, tbl, tid); }
    __device__ __forceinline__ void init(Acc& acc, const Unit& u, int wr, int wc, int fr, int fq) const {
        if (GATE) { zero_acc(acc); return; }
        const float* base = xin + (size_t)(u.pm * BM + wr * 64 + fr) * DM + u.pn * BM + wc * 32 + 4 * fq;
#pragma unroll
        for (int ai = 0; ai < 2; ++ai)
#pragma unroll
            for (int m = 0; m < 4; ++m)
#pragma unroll
                for (int bj = 0; bj < 2; ++bj)
#pragma unroll
                    for (int n = 0; n < 2; ++n) acc[ai][bj][m][n] = *(const f32x4*)(base + (size_t)(ai * HALF + m * 16) * DM + bj * HALF + n * 16);
    }
    __device__ __forceinline__ void operator()(const Acc& acc, const Unit& u, int wr, int wc, int fr, int fq, const LAS float* rt) const {
        const int row0 = u.pm * BM + wr * 64 + fr, col0 = u.pn * BM + wc * 32 + 4 * fq;
        f32x4 bvs[4];
        if (GATE) {
#pragma unroll
            for (int q = 0; q < 4; ++q) bvs[q] = *(const f32x4*)(bias + col0 + (q >> 1) * HALF + (q & 1) * 16);
        }
#pragma unroll
        for (int ai = 0; ai < 2; ++ai)
#pragma unroll
            for (int mp = 0; mp < 2; ++mp) {
                f32x4 xis[8]; u32x2 ebs[8];
                if (GATE) {
#pragma unroll
                    for (int k = 0; k < 8; ++k) { const size_t off = (size_t)(row0 + ai * HALF + (2 * mp + (k >> 2)) * 16) * DM + col0 + ((k >> 1) & 1) * HALF + (k & 1) * 16;
                        xis[k] = *(const f32x4*)(xin + off); ebs[k] = *(const u32x2*)(Eb + off); }
                }
#pragma unroll
                for (int mm = 0; mm < 2; ++mm) {
                    const int m = 2 * mp + mm; const int row = row0 + ai * HALF + m * 16; float r = 0.f; if (GATE) r = rt[ai * HALF + wr * 64 + m * 16 + fr];
                    float sq = 0.f;
#pragma unroll
                    for (int bj = 0; bj < 2; ++bj)
#pragma unroll
                        for (int n = 0; n < 2; ++n) {
                            const int c = col0 + bj * HALF + n * 16; const size_t off = (size_t)row * DM + c;
                            const f32x4 a = acc[ai][bj][m][n]; f32x4 xo;
                            if (GATE) { const int k = mm * 4 + bj * 2 + n; const f32x4 xi = xis[k]; const f32x4 bv = bvs[bj * 2 + n]; const u32x2 eb = ebs[k];
                                xo[0] = xi[0] + sigmoidf_(a[0] * r + bv[0]) * bflo(eb.x); xo[1] = xi[1] + sigmoidf_(a[1] * r + bv[1]) * bfhi(eb.x);
                                xo[2] = xi[2] + sigmoidf_(a[2] * r + bv[2]) * bflo(eb.y); xo[3] = xi[3] + sigmoidf_(a[3] * r + bv[3]) * bfhi(eb.y); }
                            else xo = a;
                            __builtin_nontemporal_store(xo, (f32x4*)(xout + off));
                            u32x2 w; w.x = cvtpk(xo[0], xo[1]); w.y = cvtpk(xo[2], xo[3]); *(u32x2*)(xb + off) = w;
                            sq += (xo[0] * xo[0] + xo[1] * xo[1]) + (xo[2] * xo[2] + xo[3] * xo[3]);
                        }
                    sq += __shfl_xor(sq, 16); sq += __shfl_xor(sq, 32);
                    if (fq == 0) ss_out[(size_t)row * 16 + u.pn * 4 + wc] = sq;
                }
            }
    }
};
struct EpiProj {
    static constexpr bool PERM = true;
    __device__ __forceinline__ void init(Acc& acc, const Unit&, int, int, int, int) const { zero_acc(acc); }
    __device__ __forceinline__ void prep(int pm, int& prev_pm, int& tb, LAS float* tbl, int tid) const { rstd_prep(ss, pm, prev_pm, tb, tbl, tid); }
    bf16_t* O; const float* ss; const float* qn; const float* kn; LAS float* P;
    __device__ __forceinline__ void operator()(const Acc& acc, const Unit& u, int wr, int wc, int fr, int fq, const LAS float* rt) const {
        const int row0 = u.pm * BM + wr * 64 + fr; int colt = u.pn * BM; const int t = colt >> 10; colt -= t << 10;
        bf16_t* base = O + (size_t)t * ((size_t)T * DM); const int col0 = colt + wc * 32 + 8 * fq;
        if (t == 2 || t == 3) {
            float rx[8];
#pragma unroll
            for (int ai = 0; ai < 2; ++ai)
#pragma unroll
                for (int m = 0; m < 4; ++m) {
                    const int rl = ai * HALF + wr * 64 + m * 16 + fr; const float r = rt[rl]; rx[ai * 4 + m] = r;
#pragma unroll
                    for (int bj = 0; bj < 2; ++bj) { const f32x4 v0 = acc[ai][bj][m][0] * r, v1 = acc[ai][bj][m][1] * r;
                        float s = (v0[0] * v0[0] + v0[1] * v0[1]) + (v0[2] * v0[2] + v0[3] * v0[3]) + (v1[0] * v1[0] + v1[1] * v1[1]) + (v1[2] * v1[2] + v1[3] * v1[3]);
                        s += __shfl_xor(s, 16); s += __shfl_xor(s, 32);
                        if (fq == 0) P[(rl * 2 + bj) * 4 + wc] = s; }
                }
            asm volatile("s_waitcnt lgkmcnt(0)" ::: "memory"); __builtin_amdgcn_s_barrier(); asm volatile("" ::: "memory");
            const float* gp = (t == 2 ? qn : kn) + wc * 32 + 8 * fq; const f32x4 g0 = *(const f32x4*)gp, g1 = *(const f32x4*)(gp + 4);
            const float qs = (t == 2) ? 0.08838834764831845f * LOG2E : 1.f;
#pragma unroll
            for (int ai = 0; ai < 2; ++ai)
#pragma unroll
                for (int m = 0; m < 4; ++m) {
                    const int rl = ai * HALF + wr * 64 + m * 16 + fr; const float r = rx[ai * 4 + m];
#pragma unroll
                    for (int bj = 0; bj < 2; ++bj) { const f32x4 pp = *(const LAS f32x4*)(P + (rl * 2 + bj) * 4);
                        const float rn = rsqrtf(((pp[0] + pp[1]) + (pp[2] + pp[3])) * (1.f / HD) + EPS) * qs * r;
                        const f32x4 v0 = acc[ai][bj][m][0] * rn * g0, v1 = acc[ai][bj][m][1] * rn * g1;
                        u32x4 w; w.x = cvtpk(v0[0], v0[1]); w.y = cvtpk(v0[2], v0[3]); w.z = cvtpk(v1[0], v1[1]); w.w = cvtpk(v1[2], v1[3]);
                        __builtin_nontemporal_store(w, (u32x4*)(base + (size_t)(u.pm * BM + rl) * DM + col0 + bj * HALF)); }
                }
            return;
        }
#pragma unroll
        for (int ai = 0; ai < 2; ++ai)
#pragma unroll
            for (int m = 0; m < 4; ++m) {
                const int row = row0 + ai * HALF + m * 16; const float r = rt[ai * HALF + wr * 64 + m * 16 + fr];
#pragma unroll
                for (int bj = 0; bj < 2; ++bj) { const f32x4 v0 = acc[ai][bj][m][0] * r, v1 = acc[ai][bj][m][1] * r;
                    u32x4 w; w.x = cvtpk(v0[0], v0[1]); w.y = cvtpk(v0[2], v0[3]); w.z = cvtpk(v1[0], v1[1]); w.w = cvtpk(v1[2], v1[3]);
                    __builtin_nontemporal_store(w, (u32x4*)(base + (size_t)row * DM + col0 + bj * HALF)); }
            }
    }
};
struct EpiPlain {
    static constexpr bool PERM = true;
    __device__ __forceinline__ void init(Acc& acc, const Unit&, int, int, int, int) const { zero_acc(acc); }
    __device__ __forceinline__ void prep(int, int&, int&, LAS float*, int) const {}
    bf16_t* O;
    __device__ __forceinline__ void operator()(const Acc& acc, const Unit& u, int wr, int wc, int fr, int fq, const LAS float* rt) const {
        const int row0 = u.pm * BM + wr * 64 + fr, col0 = u.pn * BM + wc * 32 + 8 * fq;
#pragma unroll
        for (int ai = 0; ai < 2; ++ai)
#pragma unroll
            for (int m = 0; m < 4; ++m) {
                const int row = row0 + ai * HALF + m * 16;
#pragma unroll
                for (int bj = 0; bj < 2; ++bj) { const f32x4 v0 = acc[ai][bj][m][0], v1 = acc[ai][bj][m][1];
                    u32x4 w; w.x = cvtpk(v0[0], v0[1]); w.y = cvtpk(v0[2], v0[3]); w.z = cvtpk(v1[0], v1[1]); w.w = cvtpk(v1[2], v1[3]);
                    __builtin_nontemporal_store(w, (u32x4*)(O + (size_t)row * DM + col0 + bj * HALF)); }
            }
    }
};
struct EpiGate {
    static constexpr bool PERM = true;
    __device__ __forceinline__ void init(Acc& acc, const Unit&, int, int, int, int) const { zero_acc(acc); }
    __device__ __forceinline__ void prep(int, int&, int&, LAS float*, int) const {}
    const bf16_t* rxc; bf16_t* L; bf16_t* U; const float* ba; const float* bx; const float* sp8;
    __device__ __forceinline__ void operator()(const Acc& acc, const Unit& u, int wr, int wc, int fr, int fq, const LAS float* rt) const {
        const int row0 = u.pm * BM + wr * 64 + fr, c0 = u.pn * 128 + wc * 32 + 8 * fq;
        asm volatile("" ::: "memory");
        u32x4 xq0 = *(const u32x4*)(rxc + (size_t)row0 * DM + c0), xq1 = *(const u32x4*)(rxc + (size_t)(row0 + 16) * DM + c0);
#pragma unroll
        for (int ai = 0; ai < 2; ++ai)
#pragma unroll
            for (int m = 0; m < 4; ++m) {
                const int row = row0 + ai * HALF + m * 16; const size_t off = (size_t)row * DM + c0;
                const u32x4 xr = xq0; xq0 = xq1;
                { const int k2 = ai * 4 + m + 2; if (k2 < 8) xq1 = *(const u32x4*)(rxc + (size_t)(row0 + (k2 >> 2) * HALF + (k2 & 3) * 16) * DM + c0); }
                const float xc[8] = {bflo(xr.x), bfhi(xr.x), bflo(xr.y), bfhi(xr.y), bflo(xr.z), bfhi(xr.z), bflo(xr.w), bfhi(xr.w)};
                unsigned wl[4], wu[4];
#pragma unroll
                for (int n = 0; n < 2; ++n) {
                    const f32x4 vba = *(const f32x4*)(ba + c0 + 4 * n), vbx = *(const f32x4*)(bx + c0 + 4 * n), vsp = *(const f32x4*)(sp8 + c0 + 4 * n);
                    float la[4], uu[4];
#pragma unroll
                    for (int e = 0; e < 4; ++e) {
                        const float rg = sigmoidf_(acc[ai][0][m][n][e] + vba[e]), ig = sigmoidf_(acc[ai][1][m][n][e] + vbx[e]);
                        const float l = -vsp[e] * rg, y = 2.f * l;
                        const float om = (y > -0.01f) ? -y * (1.f + y * (0.5f + y * (1.f / 6.f))) : 1.f - __builtin_amdgcn_exp2f(y * LOG2E);
                        la[e] = l; uu[e] = __builtin_amdgcn_sqrtf(om) * ig * xc[n * 4 + e]; }
                    wl[2 * n] = cvtpk(la[0], la[1]); wl[2 * n + 1] = cvtpk(la[2], la[3]); wu[2 * n] = cvtpk(uu[0], uu[1]); wu[2 * n + 1] = cvtpk(uu[2], uu[3]);
                }
                __builtin_nontemporal_store((u32x4){wl[0], wl[1], wl[2], wl[3]}, (u32x4*)(L + off)); __builtin_nontemporal_store((u32x4){wu[0], wu[1], wu[2], wu[3]}, (u32x4*)(U + off));
                asm volatile("" ::: "memory");
            }
    }
};
template <bool ADD> struct EpiMerge {
    static constexpr bool PERM = true;
    __device__ __forceinline__ void init(Acc& acc, const Unit&, int, int, int, int) const { zero_acc(acc); }
    __device__ __forceinline__ void prep(int, int&, int&, LAS float*, int) const {}
    const bf16_t* Gt; const float* mb; const bf16_t* prev; bf16_t* O;
    __device__ __forceinline__ void operator()(const Acc& acc, const Unit& u, int wr, int wc, int fr, int fq, const LAS float* rt) const {
        const int row0 = u.pm * BM + wr * 64 + fr, col0 = u.pn * BM + wc * 32 + 8 * fq;
#pragma unroll
        for (int bj = 0; bj < 2; ++bj) {
            const int c = col0 + bj * HALF; float vmb[8];
#pragma unroll
            for (int j = 0; j < 8; ++j) vmb[j] = mb[c + j];
#pragma unroll
            for (int ai = 0; ai < 2; ++ai) {
            asm volatile("" ::: "memory");
            u32x4 gr[4], pr[4];
#pragma unroll
            for (int k = 0; k < 4; ++k) { const size_t off = (size_t)(row0 + ai * HALF + k * 16) * DM + c;
                gr[k] = *(const u32x4*)(Gt + off); if (ADD) pr[k] = *(const u32x4*)(prev + off); }
#pragma unroll
            for (int k = 0; k < 4; ++k) {
                const int m = k; const size_t off = (size_t)(row0 + ai * HALF + m * 16) * DM + c;
                const float gv[8] = {bflo(gr[k].x), bfhi(gr[k].x), bflo(gr[k].y), bfhi(gr[k].y), bflo(gr[k].z), bfhi(gr[k].z), bflo(gr[k].w), bfhi(gr[k].w)};
                float pv[8] = {0.f, 0.f, 0.f, 0.f, 0.f, 0.f, 0.f, 0.f};
                if (ADD) { pv[0] = bflo(pr[k].x); pv[1] = bfhi(pr[k].x); pv[2] = bflo(pr[k].y); pv[3] = bfhi(pr[k].y); pv[4] = bflo(pr[k].z); pv[5] = bfhi(pr[k].z); pv[6] = bflo(pr[k].w); pv[7] = bfhi(pr[k].w); }
                float o[8];
#pragma unroll
                for (int n = 0; n < 2; ++n)
#pragma unroll
                    for (int e = 0; e < 4; ++e) { const int j = n * 4 + e; o[j] = pv[j] + sigmoidf_(gv[j] + vmb[j]) * acc[ai][bj][m][n][e]; }
                u32x4 w; w.x = cvtpk(o[0], o[1]); w.y = cvtpk(o[2], o[3]); w.z = cvtpk(o[4], o[5]); w.w = cvtpk(o[6], o[7]);
                *(u32x4*)(O + off) = w;
            }
            }
        }
    }
};
}

namespace att {
using bf16 = __hip_bfloat16;
constexpr int NW = 8, QBLK = 32, KVBLK = 64, QB = NW * QBLK, D = 128, LD = 1024;
constexpr int SHM_V = KVBLK * D * 2, SHM_K = KVBLK * D * 2;
constexpr int OFF_WS = 2 * SHM_V + 2 * SHM_K, OFF_KB = OFF_WS + NW * 64 * 4, ATT_LDS = OFF_KB + 2 * 64 * 4;
constexpr float THR = 8.f;
#define KSWZ(row, colB) ((row) * 256 + ((colB) ^ (((row) & 7) << 4)))
#define SBAR() __builtin_amdgcn_sched_barrier(0)
__device__ __forceinline__ int v_st(int k, int c) { const int kk = (k & ~0xC) | ((k & 4) << 1) | ((k & 8) >> 1); return ((kk >> 3) * 4 + (c >> 5)) * 512 + ((kk & 7) * 32 + (c & 31)) * 2; }
__device__ __forceinline__ int v_rd_base(int lane) { return ((lane & 3) << 3) | (((lane >> 2) & 3) << 6) | (((lane >> 4) & 1) << 5) | (((lane >> 5) & 1) << 8); }
constexpr int v_rd_off(int d0, int ks, int half) { return d0 * 512 + ks * 4096 + half * 2048; }
__device__ __forceinline__ int crow(int r, int hi) { return (r & 3) + 8 * (r >> 2) + 4 * hi; }
__device__ __forceinline__ bf16x8 load8(const bf16* p) { return *reinterpret_cast<const bf16x8*>(p); }
__device__ __forceinline__ void mask_tile(f32x16& p0, f32x16& p1, int dq) {
    const float NEG = -__builtin_inff();
#pragma unroll
    for (int r = 0; r < 16; ++r) {
        const int c = (r & 3) + 8 * (r >> 2);
        if (dq - c < 0) p0[r] = NEG;
        if (dq - c - 32 < 0) p1[r] = NEG;
    }
}
__device__ __forceinline__ void partialSM(f32x16& p0, f32x16& p1, float& m_reg, float& mn, float& alpha) {
    float pmax = p0[0];
#pragma unroll
    for (int r = 1; r < 16; ++r) pmax = fmaxf(pmax, p0[r]);
#pragma unroll
    for (int r = 0; r < 16; ++r) pmax = fmaxf(pmax, p1[r]);
    { auto rr = __builtin_amdgcn_permlane32_swap(__float_as_uint(pmax), __float_as_uint(pmax), false, false);
      pmax = fmaxf(__uint_as_float(rr[0]), __uint_as_float(rr[1])); }
    if (__builtin_expect(__all((pmax - m_reg) <= THR), 1)) { mn = m_reg; alpha = 1.f; }
    else { mn = fmaxf(m_reg, pmax); alpha = __builtin_amdgcn_exp2f(m_reg - mn); m_reg = mn; }
#pragma unroll
    for (int r = 0; r < 16; ++r) p0[r] = p0[r] - mn;
#pragma unroll
    for (int r = 0; r < 16; ++r) p1[r] = p1[r] - mn;
#pragma unroll
    for (int r = 0; r < 16; ++r) p0[r] = __builtin_amdgcn_exp2f(p0[r]);
}
__device__ __forceinline__ void finishSM(f32x16& p0, f32x16& p1, float alpha, float& l_reg, bf16x8& pa0, bf16x8& pa1, bf16x8& pa2, bf16x8& pa3) {
#pragma unroll
    for (int r = 0; r < 16; ++r) p1[r] = __builtin_amdgcn_exp2f(p1[r]);
    float ps = 0;
#pragma unroll
    for (int r = 0; r < 16; ++r) ps += p0[r];
#pragma unroll
    for (int r = 0; r < 16; ++r) ps += p1[r];
    { auto rr = __builtin_amdgcn_permlane32_swap(__float_as_uint(ps), __float_as_uint(ps), false, false);
      ps = __uint_as_float(rr[0]) + __uint_as_float(rr[1]); }
    l_reg = l_reg * alpha + ps;
#define PK4(P, B_, OUT) do { unsigned a0 = cvtpk(P[B_+0], P[B_+1]), a1 = cvtpk(P[B_+2], P[B_+3]);                          \
        unsigned b0 = cvtpk(P[B_+4], P[B_+5]), b1 = cvtpk(P[B_+6], P[B_+7]);                                             \
        auto r0 = __builtin_amdgcn_permlane32_swap(a0, b0, false, false); auto r1 = __builtin_amdgcn_permlane32_swap(a1, b1, false, false); \
        u32x4 w = {r0[0], r1[0], r0[1], r1[1]}; OUT = *reinterpret_cast<bf16x8*>(&w); } while (0)
    PK4(p0, 0, pa0); PK4(p0, 8, pa1); PK4(p1, 0, pa2); PK4(p1, 8, pa3);
#undef PK4
}
template <int KB>
__device__ __forceinline__ void qkt(f32x16& p0, f32x16& p1, const char* K_lds, const float* kbias, int r32, int hi, const bf16x8* qr) {
    { const float* kb_ = kbias + KB * 64 + 4 * hi;
#pragma unroll
      for (int g = 0; g < 4; ++g) { const f32x4 b0 = *(const f32x4*)(kb_ + 8 * g), b1 = *(const f32x4*)(kb_ + 32 + 8 * g);
#pragma unroll
          for (int j = 0; j < 4; ++j) { p0[4 * g + j] = b0[j]; p1[4 * g + j] = b1[j]; } } }
    const char* kb[4];
#pragma unroll
    for (int dd = 0; dd < 4; ++dd) kb[dd] = K_lds + KB * SHM_K + KSWZ(r32, (dd * 16 + hi * 8) * 2);
#pragma unroll
    for (int d0 = 0; d0 < 8; ++d0) { const char* a = kb[d0 & 3] + (d0 >> 2) * 128;
        bf16x8 b0 = *reinterpret_cast<const bf16x8*>(a);
        bf16x8 b1 = *reinterpret_cast<const bf16x8*>(a + 32 * 256);
        p0 = __builtin_amdgcn_mfma_f32_32x32x16_bf16(b0, qr[d0], p0, 0, 0, 0);
        p1 = __builtin_amdgcn_mfma_f32_32x32x16_bf16(b1, qr[d0], p1, 0, 0, 0); }
}
template <int VB>
__device__ __forceinline__ void pv_tile(f32x16* o, int vb0, bf16x8 pa0, bf16x8 pa1, bf16x8 pa2, bf16x8 pa3) {
#define TRRD(dst, off) asm volatile("ds_read_b64_tr_b16 %0, %1 offset:%2" : "=&v"(dst) : "v"(vb0), "i"(off) : "memory")
#define PV_D0(d0) do { s16x4 l0, l1, l2, l3, h0, h1, h2, h3; constexpr int b_ = VB * SHM_V + v_rd_off(d0, 0, 0); \
        TRRD(l0, b_); TRRD(h0, b_ + 2048); TRRD(l1, b_ + 4096); TRRD(h1, b_ + 6144); TRRD(l2, b_ + 8192); TRRD(h2, b_ + 10240); TRRD(l3, b_ + 12288); TRRD(h3, b_ + 14336); \
        asm volatile("s_waitcnt lgkmcnt(0)" ::: "memory"); SBAR(); \
        o[d0] = __builtin_amdgcn_mfma_f32_32x32x16_bf16(pa0, (bf16x8){l0[0], l0[1], l0[2], l0[3], h0[0], h0[1], h0[2], h0[3]}, o[d0], 0, 0, 0);   \
        o[d0] = __builtin_amdgcn_mfma_f32_32x32x16_bf16(pa1, (bf16x8){l1[0], l1[1], l1[2], l1[3], h1[0], h1[1], h1[2], h1[3]}, o[d0], 0, 0, 0);   \
        o[d0] = __builtin_amdgcn_mfma_f32_32x32x16_bf16(pa2, (bf16x8){l2[0], l2[1], l2[2], l2[3], h2[0], h2[1], h2[2], h2[3]}, o[d0], 0, 0, 0);   \
        o[d0] = __builtin_amdgcn_mfma_f32_32x32x16_bf16(pa3, (bf16x8){l3[0], l3[1], l3[2], l3[3], h3[0], h3[1], h3[2], h3[3]}, o[d0], 0, 0, 0); } while (0)
    PV_D0(0); PV_D0(1); PV_D0(2); PV_D0(3);
#undef PV_D0
#undef TRRD
}
struct BlockRef { const bf16* Q; const bf16* K; const bf16* V; bf16* O; const float* ND; int P0; int jlo; };
struct Seam { bf16x8 qr[8]; bf16x8 st_v0, st_v1, st_k0, st_k1; };
#define ROW(p, k0, rr) ((p) + (size_t)((k0) + (rr)) * LD + sc)
#define VMW() asm volatile("s_waitcnt vmcnt(0)" ::: "memory")
#define VMWN(n) asm volatile("s_waitcnt vmcnt(%0)" :: "i"(n) : "memory")
#define SLOAD_H(Kp, Vp, NDp, k0, bf) do { S.st_v0 = load8(ROW(Vp, k0, sr)); S.st_v1 = load8(ROW(Vp, k0, 32 + sr));              \
                         S.st_k0 = load8(ROW(Kp, k0, sr)); S.st_k1 = load8(ROW(Kp, k0, 32 + sr));                              \
                         if (wid == 0) __builtin_amdgcn_global_load_lds((const unsigned*)((NDp) + (k0) + lane), (LAS unsigned*)(kbias3 + (bf) * 64), 4, 0, 0); } while (0)
#define SWRITE_HK(bf) do { *(bf16x8*)(K_lds + (bf) * SHM_K + kws) = S.st_k0; *(bf16x8*)(K_lds + (bf) * SHM_K + kws + 32 * 256) = S.st_k1; } while (0)
#define SWRITE_HV(bf) do { *(bf16x8*)(V_lds + (bf) * SHM_V + vst0) = S.st_v0; *(bf16x8*)(V_lds + (bf) * SHM_V + vst1) = S.st_v1; } while (0)
#define SWRITE_H(bf) do { SWRITE_HV(bf); SWRITE_HK(bf); } while (0)
__device__ __forceinline__ void attn_prime(const BlockRef& cur, char* lds, Seam& S) {
    int tid = threadIdx.x; asm volatile("" : "+v"(tid)); const int wid = __builtin_amdgcn_readfirstlane(tid >> 6), lane = tid & 63, r32 = lane & 31, hi = lane >> 5;
    const int sr = tid >> 4, sc = (tid & 15) * 8, kws = KSWZ(sr, sc * 2); char* K_lds = lds + 2 * SHM_V; LAS float* kbias3 = (LAS float*)(LAS char*)lds + OFF_KB / 4;
#pragma unroll
    for (int d0 = 0; d0 < 8; ++d0) S.qr[d0] = load8(cur.Q + (size_t)(wid * QBLK + r32) * LD + d0 * 16 + hi * 8);
    SLOAD_H(cur.K, cur.V, cur.ND, cur.P0 + QB - KVBLK, 0); VMW(); SWRITE_HK(0);
    __syncthreads();
}
__device__ __forceinline__ void attn_block(const BlockRef& cur, const BlockRef& nxt, char* lds, Seam& S) {
    int tid = threadIdx.x; asm volatile("" : "+v"(tid)); const int wid = __builtin_amdgcn_readfirstlane(tid >> 6), lane = tid & 63, r32 = lane & 31, hi = lane >> 5;
    const int j_lo = cur.jlo, NT = (cur.P0 + QB) / KVBLK - j_lo;
    const int qlo = cur.P0 + wid * QBLK, qm = qlo + r32 - 4 * hi;
    char* V_lds = lds; char* K_lds = lds + 2 * SHM_V; const float* kbias = (const float*)(lds + OFF_KB); LAS float* kbias3 = (LAS float*)(LAS char*)lds + OFF_KB / 4;
    float* ws = (float*)(lds + OFF_WS) + wid * 64; float* li_l = ws, * al_l = ws + 32;
    float m_reg = -1e30f, l_reg = 0; f32x16 o[4] = {};
    const int sr = tid >> 4, sc = (tid & 15) * 8, vst0 = v_st(sr, sc), vst1 = v_st(32 + sr, sc), kws = KSWZ(sr, sc * 2);
    const int vb0 = (int)(uintptr_t)V_lds + v_rd_base(lane);
    const bf16* Kh = cur.K; const bf16* Vh = cur.V; const float* NDh = cur.ND;
#define RESC(a) do { if (__any((a) < 1.f)) { if (hi == 0) al_l[r32] = (a); asm volatile("s_waitcnt lgkmcnt(0)" ::: "memory");              \
                     for (int d_ = 0; d_ < 4; ++d_) for (int r = 0; r < 16; ++r) o[d_][r] *= al_l[crow(r, hi)]; } } while (0)
#define KBASE(t) ((j_lo + NT - 1 - (t)) * KVBLK)
#define MASKT(P0_, P1_, t) do { const int kb_ = KBASE(t); if (kb_ + KVBLK - 1 > qlo) mask_tile(P0_, P1_, qm - kb_); } while (0)
#define SEAM_K0() do { VMWN(8); SWRITE_HK(0); SBAR(); } while (0)
    f32x16 pA0, pA1, pB0, pB1; float mnA, mnB, alA, alB; bf16x8 pa0, pa1, pa2, pa3;
    SWRITE_HV(0); SBAR();
    SLOAD_H(Kh, Vh, NDh, KBASE(1), 1);
    SBAR(); qkt<0>(pA0, pA1, K_lds, kbias, r32, hi, S.qr);
    MASKT(pA0, pA1, 0); partialSM(pA0, pA1, m_reg, mnA, alA);
    VMW(); SWRITE_H(1);
    __syncthreads();
#define HALF_STEP(PX0, PX1, mnX, alX, PY0, PY1, alY, t, KB, VB, SB) do {                                                      \
        SBAR(); qkt<KB>(PX0, PX1, K_lds, kbias, r32, hi, S.qr);                                                               \
        finishSM(PY0, PY1, alY, l_reg, pa0, pa1, pa2, pa3); SBAR();                                                           \
        if ((t) + 1 < NT) { SLOAD_H(Kh, Vh, NDh, KBASE((t) + 1), SB); SBAR(); }                                               \
        pv_tile<VB>(o, vb0, pa0, pa1, pa2, pa3); MASKT(PX0, PX1, (t)); partialSM(PX0, PX1, m_reg, mnX, alX);                  \
        __syncthreads();                                                                                                      \
        if ((t) + 1 < NT) { VMW(); SWRITE_H(SB); }                                                                            \
        RESC(alX); __syncthreads(); } while (0)
    for (int t = 1; t + 1 < NT; t += 2) {
        HALF_STEP(pB0, pB1, mnB, alB, pA0, pA1, alA, t, 1, 0, 0);
        HALF_STEP(pA0, pA1, mnA, alA, pB0, pB1, alB, t + 1, 0, 1, 1);
    }
    SBAR(); qkt<1>(pB0, pB1, K_lds, kbias, r32, hi, S.qr); SBAR();
    SLOAD_H(nxt.K, nxt.V, nxt.ND, nxt.P0 + QB - KVBLK, 0); SBAR();
#pragma unroll
    for (int d0 = 0; d0 < 8; ++d0) S.qr[d0] = load8(nxt.Q + (size_t)(wid * QBLK + r32) * LD + d0 * 16 + hi * 8);
    SBAR();
    finishSM(pA0, pA1, alA, l_reg, pa0, pa1, pa2, pa3); SBAR();
    pv_tile<0>(o, vb0, pa0, pa1, pa2, pa3);
    MASKT(pB0, pB1, NT - 1); partialSM(pB0, pB1, m_reg, mnB, alB); __syncthreads(); RESC(alB);
    finishSM(pB0, pB1, alB, l_reg, pa0, pa1, pa2, pa3); SBAR(); pv_tile<1>(o, vb0, pa0, pa1, pa2, pa3);
    SBAR(); SEAM_K0();
    if (hi == 0) li_l[r32] = l_reg; asm volatile("s_waitcnt lgkmcnt(0)" ::: "memory");
    float rli[16];
#pragma unroll
    for (int r = 0; r < 16; ++r) rli[r] = __builtin_amdgcn_rcpf(li_l[crow(r, hi)]);
    bf16* Ow = cur.O + (size_t)(wid * QBLK) * LD;
#pragma unroll
    for (int r = 0; r < 16; ++r) { const int orow = crow(r, hi);
#pragma unroll
        for (int d0 = 0; d0 < 4; ++d0) { const float v = o[d0][r] * rli[r];
            const float vn = __shfl_xor(v, 1);
            if ((r32 & 1) == 0) *(unsigned*)(Ow + (size_t)orow * LD + d0 * 32 + r32) = cvtpk(v, vn); } }
    __syncthreads();
#undef RESC
#undef KBASE
#undef MASKT
#undef SEAM_K0
#undef HALF_STEP
}
#undef ROW
#undef VMW
#undef VMWN
#undef SLOAD_H
#undef SWRITE_HK
#undef SWRITE_HV
#undef SWRITE_H
__device__ __forceinline__ float ld_agent(const float* p) { const float v = __hip_atomic_load(p, __ATOMIC_RELAXED, __HIP_MEMORY_SCOPE_AGENT); return __uint_as_float(__builtin_amdgcn_readfirstlane(__float_as_uint(v))); }
__device__ __forceinline__ BlockRef mk_ref(int i, float C, const bf16* Q, const bf16* K, const bf16* V, bf16* O, const float* ND) {
    const int bh = i & 31, qb = 31 - (i >> 5), b = bh >> 3, h = bh & 7;
    const size_t hoff = (size_t)b * SEQ * LD + (size_t)h * D;
    BlockRef r; r.P0 = qb * QB;
    r.Q = Q + hoff + (size_t)r.P0 * LD; r.O = O + hoff + (size_t)r.P0 * LD; r.K = K + hoff; r.V = V + hoff; r.ND = ND + (size_t)bh * SEQ;
    const float thr = ld_agent(r.ND + r.P0) - C;
    int lo = 0, hi = r.P0 / KVBLK;
    while (lo < hi) { const int mid = (lo + hi) >> 1; if (ld_agent(r.ND + mid * KVBLK + KVBLK - 1) >= thr) hi = mid; else lo = mid + 1; }
    r.jlo = __builtin_amdgcn_readfirstlane(lo & ~1);
    return r;
}
__device__ __forceinline__ void attn_phase(char* lds, const bf16* Q, const bf16* K, const bf16* V, bf16* O, const float* ND, unsigned* ctr, const float* qn, const float* kn) {
    constexpr int total = NB * NH * 32;
    volatile int* slot = (volatile int*)(lds + ATT_LDS);
    int tid = threadIdx.x; asm volatile("" : "+v"(tid));
    float C;
    { float gq = 0.f, gk = 0.f;
      for (int j = 0; j < D; ++j) { gq = fmaxf(gq, fabsf(qn[j])); gk = fmaxf(gk, fabsf(kn[j])); }
      C = 2.f * 16.65f * gq * gk + 32.f + ((PROBE == 7) ? 75.f : 0.f); C = __uint_as_float(__builtin_amdgcn_readfirstlane(__float_as_uint(C))); }
    if (tid == 0) slot[0] = (int)atomicAdd(ctr, 1u);
    __syncthreads();
    int L = slot[0]; L = __builtin_amdgcn_readfirstlane(L);
    if (L >= total) return;
    BlockRef cur = mk_ref(L, C, Q, K, V, O, ND);
    if (tid == 0) slot[1] = (int)atomicAdd(ctr, 1u);
    Seam S;
    attn_prime(cur, lds, S);
    for (int it = 1;; ++it) {
        int Ln = slot[it & 1]; Ln = __builtin_amdgcn_readfirstlane(Ln);
        const bool last = Ln >= total;
        const BlockRef nxt = last ? cur : mk_ref(Ln, C, Q, K, V, O, ND);
        if (!last && tid == 0) slot[(it + 1) & 1] = (int)atomicAdd(ctr, 1u);
        attn_block(cur, nxt, lds, S);
        if (last) break;
        cur = nxt;
    }
}
#undef KSWZ
#undef SBAR
}


#define XB_TMO      128
#define XB_XCNT(j)  (256  + 64 * (j))
#define XB_XSUB(j)  (1280 + 64 * (j))
#define XB_XGEN(j)  (2304 + 64 * (j))
#define XB_TOP      3328
#define XB_TOPGEN   3392
#define XCD_BAR_WORDS 3456
#define XB_SPIN_CAP (1u << 22)
constexpr size_t WS_BAR = WS_VEC + 524288;
constexpr int LDS_BARST = LDS_BYTES - 64;
__device__ __forceinline__ unsigned xb_ld(unsigned* p)              { return __hip_atomic_load(p, __ATOMIC_RELAXED, __HIP_MEMORY_SCOPE_AGENT); }
__device__ __forceinline__ unsigned xb_add(unsigned* p, unsigned v) { return __hip_atomic_fetch_add(p, v, __ATOMIC_RELAXED, __HIP_MEMORY_SCOPE_AGENT); }
__device__ __forceinline__ unsigned xb_xcc_id() { return (unsigned)__builtin_amdgcn_s_getreg((3 << 11) | 20) & 0xFu; }
#define XB_SPIN(cond, bar) do { unsigned _sp = 0; while (cond) { __builtin_amdgcn_s_sleep(1); \
    if ((++_sp & 255u) == 0u) { if (xb_ld(&(bar)[XB_TMO])) break; if (_sp > XB_SPIN_CAP) { atomicAdd(&(bar)[XB_TMO], 1u); break; } } } } while (0)
__device__ __forceinline__ void xcd_barrier_complete(unsigned* bar, unsigned x, unsigned& nloc, unsigned& nx) {
    const unsigned G = gridDim.x * gridDim.y * gridDim.z;
    unsigned sum, cnt, mine, sp = 0u;
    for (;;) {
        sum = 0u; cnt = 0u; mine = 0u;
#pragma unroll
        for (unsigned j = 0; j < 16; ++j) { const unsigned c = xb_ld(&bar[XB_XCNT(j)]); sum += c; cnt += (c > 0u) ? 1u : 0u; mine = (j == x) ? c : mine; }
        if (sum == G) break;
        __builtin_amdgcn_s_sleep(1);
        if ((++sp & 255u) == 0u) { if (xb_ld(&bar[XB_TMO])) break; if (sp > XB_SPIN_CAP) { atomicAdd(&bar[XB_TMO], 1u); break; } }
    }
    nloc = mine > 0u ? mine : 1u; nx = cnt > 0u ? cnt : 1u;
}
__device__ __forceinline__ void xcd_barrier(unsigned* bar, volatile LAS unsigned* st) {
    asm volatile("s_waitcnt vmcnt(0)" ::: "memory");
    __syncthreads();
    if (threadIdx.x == 0) {
        const unsigned x = xb_xcc_id();
        __builtin_amdgcn_s_waitcnt(0);
        unsigned nloc = st[0], nx = st[1];
        if (nloc == 0u) { xcd_barrier_complete(bar, x, nloc, nx); st[0] = nloc; st[1] = nx; }
        const unsigned old = xb_add(&bar[XB_XSUB(x)], 1u);
        const unsigned gen = old / nloc;
        if (old + 1u == (gen + 1u) * nloc) {
            __builtin_amdgcn_fence(__ATOMIC_RELEASE, "agent");
            asm volatile("s_waitcnt vmcnt(0)" ::: "memory");
            const unsigned og = xb_add(&bar[XB_TOP], 1u);
            const unsigned tg = og / nx;
            if (og + 1u == (tg + 1u) * nx) xb_add(&bar[XB_TOPGEN], 1u);
            else XB_SPIN(xb_ld(&bar[XB_TOPGEN]) == tg, bar);
            __builtin_amdgcn_fence(__ATOMIC_ACQUIRE, "agent");
            xb_add(&bar[XB_XGEN(x)], 1u);
            asm volatile("s_waitcnt vmcnt(0)" ::: "memory");
        } else {
            XB_SPIN(xb_ld(&bar[XB_XGEN(x)]) == gen, bar);
            __builtin_amdgcn_fence(__ATOMIC_ACQUIRE, "agent");
            asm volatile("s_waitcnt vmcnt(0)" ::: "memory");
        }
    }
    __syncthreads();
}
#ifndef PHMASK
#define PHMASK 0xffff
#endif
#ifndef PROBE
#define PROBE 0
#endif
__device__ __forceinline__ int opaque_i(int v) { asm volatile("" : "+s"(v)); return v; }
#define REP(n) for (int rep_ = 0, nrep_ = ((PROBE == (n)) ? opaque_i(2) : 1); rep_ < nrep_; ++rep_)
#define PH(n) ((PHMASK >> (n)) & 1)
struct Params { const float* in[29]; float* out; unsigned char* ws; };
enum { I_X = 0, I_P, I_F1N, I_F1IN, I_F1OUT, I_MIXN, I_WIN, I_MERGEB, I_CONVW, I_CONVB, I_RGWA, I_RGBA, I_RGWX, I_RGBX, I_RGLAM, I_FB, I_QN, I_KN,
       I_WRNN, I_WATT, I_WO, I_F2N, I_F2IN, I_F2OUT, I_PLEN, I_PLEWG, I_PLEBG, I_PLEWP, I_FINALN };

__device__ __forceinline__ float wave_sum(float v) {
#pragma unroll
    for (int o = 1; o < 64; o <<= 1) v += __shfl_xor(v, o);
    return v;
}
__device__ __forceinline__ void tr_item(const float* W, int ldw, int scol, const float* gain, float wscale, bf16_t* WT, int K, int drow, int k0, LAS float* scr, int lane) {
#pragma unroll
    for (int i = 0; i < 32; ++i) { const int kk = 2 * i + (lane >> 5); float v = W[(size_t)(k0 + kk) * ldw + scol + (lane & 31)]; if (gain) v *= gain[k0 + kk]; scr[kk * 33 + (lane & 31)] = v * wscale; }
    LDS_WAIT(); asm volatile("" ::: "memory");
    const int c = lane & 7;
#pragma unroll
    for (int j = 0; j < 4; ++j) { const int n = (lane >> 3) + 8 * j; const LAS float* s = scr + (8 * c) * 33 + n;
        u32x4 o; o.x = cvtpk(s[0 * 33], s[1 * 33]); o.y = cvtpk(s[2 * 33], s[3 * 33]); o.z = cvtpk(s[4 * 33], s[5 * 33]); o.w = cvtpk(s[6 * 33], s[7 * 33]);
        *(u32x4*)(WT + (size_t)(drow + n) * K + k0 + 8 * c) = o; }
    LDS_WAIT(); asm volatile("" ::: "memory");
}
__device__ __forceinline__ bool tr_seg(int& it, const float* W, int ldw, const float* gain, float wscale, bf16_t* WT, int K, int nrows, int mode, LAS float* scr, int lane) {
    const int nblk = nrows / 32, nit = (K / 64) * nblk;
    if (it >= nit) { it -= nit; return false; }
    const int kb = it / nblk, d0 = (it % nblk) * 32; int scol = d0;
    if (mode == 1) { const int t = d0 >> 8, r = d0 & 255; scol = (r >> 7) * FF + t * 128 + (r & 127); }
    else if (mode == 2) { scol = d0 < 5120 ? d0 : d0 + 8; }
    tr_item(W, ldw, scol, gain, wscale, WT, K, d0, kb * 64, scr, lane);
    return true;
}

#define GRID_SYNC() REP(3) do { xcd_barrier((unsigned*)(P.ws + WS_BAR), (volatile LAS unsigned*)(lds + LDS_BARST)); } while (0)
#define PHASE_IDS_ int tid = threadIdx.x; asm volatile("" : "+v"(tid)); const int lane = tid & 63, wave = __builtin_amdgcn_readfirstlane(tid >> 6), gw = vcu * 8 + wave, gt = bx * 512 + tid; (void)lane; (void)gw; (void)gt;
#define ssA ((float*)(ws + WS_SS0))
#define ssB ((float*)(ws + WS_SS1))
#define logf_ ((float*)(ws + WS_LOGF))
#define nd2 ((float*)(ws + WS_ND2))
#define agg ((float*)(ws + WS_AGG))
#define sp8 ((float*)(ws + WS_VEC))
#define wfg ((float*)(ws + WS_VEC) + 4096)
#define W1in_t ((bf16_t*)(ws + WS_W1IN))
#define W1out_t ((bf16_t*)(ws + WS_W1OUT))
#define Win_t ((bf16_t*)(ws + WS_WIN))
#define Wg_t ((bf16_t*)(ws + WS_WG))
#define Wr_t ((bf16_t*)(ws + WS_WR))
#define Wat_t ((bf16_t*)(ws + WS_WAT))
#define Wo_t ((bf16_t*)(ws + WS_WO))
#define W2in_t ((bf16_t*)(ws + WS_W2IN))
#define W2out_t ((bf16_t*)(ws + WS_W2OUT))
#define Wpg_t ((bf16_t*)(ws + WS_WPG))
#define Wpe_t ((bf16_t*)(ws + WS_WPE))
#define xb ((bf16_t*)(ws + WS_XB))
#define pb ((bf16_t*)(ws + WS_PB))
#define R ((bf16_t*)(ws + WS_R))
#define X1 ((bf16_t*)(ws + WS_X1))
#define act R
#define b_rx R
#define b_rgate (R + (size_t)T * DM)
#define b_q (R + 2 * (size_t)T * DM)
#define b_k (R + 3 * (size_t)T * DM)
#define b_v (R + 4 * (size_t)T * DM)
#define b_ga (R + 5 * (size_t)T * DM)
#define b_gb (R + 6 * (size_t)T * DM)
#define xb2 b_k
#define b_rxc xb
#define b_L b_rx
#define b_U X1
#define b_ya xb
#define b_mrg X1
#define b_E X1
#define xres (P.out + zz)
#define IN(i) (P.in[(i) + zz])
#define PHASE_PTRS int zz; asm volatile("s_mov_b32 %0, 0" : "=s"(zz)); unsigned char* ws = P.ws + zz; int G = G0, bx = bx0, vcu = vcu0; asm volatile("" : "+s"(G), "+s"(bx), "+s"(vcu)); const int NGW = G * 8, NGT = G * 512; (void)NGW; (void)NGT; (void)ws;


template <int LL, int MODE> __device__ __forceinline__ void layer_prep(const Params& P, LAS unsigned char* lds, const int G0, const int bx0, const int vcu0) {
    {
            PHASE_PTRS PHASE_IDS_
            LAS float* scr = (LAS float*)(lds + wave * 16384);
            const float* f1n = IN(I_F1N) + LL * DM; const float* mixn = IN(I_MIXN) + LL * DM; const float* f2n = IN(I_F2N) + LL * DM; const float* plen = IN(I_PLEN) + LL * DM;
            const float* f1in = IN(I_F1IN) + (size_t)LL * DM * 2 * FF; const float* f1out = IN(I_F1OUT) + (size_t)LL * FF * DM;
            const float* win = IN(I_WIN) + (size_t)LL * DM * NIN;
            const float* wrnn = IN(I_WRNN) + (size_t)LL * DM * DM; const float* watt = IN(I_WATT) + (size_t)LL * DM * DM; const float* wo = IN(I_WO) + (size_t)LL * DM * DM;
            const float* f2in = IN(I_F2IN) + (size_t)LL * DM * 2 * FF; const float* f2out = IN(I_F2OUT) + (size_t)LL * FF * DM;
            const float* plewg = IN(I_PLEWG) + (size_t)LL * DM * DM; const float* plewp = IN(I_PLEWP) + (size_t)LL * PLE * DM;
            constexpr int NIT = (MODE == 2) ? 16 * 32 : 16 * 176 + 44 * 32 + 16 * 224 + 3 * 16 * 32 + 16 * 176 + 44 * 32 + 16 * 32 + 4 * 32;
            constexpr int ON = (MODE != 2) ? 1 : 0, ONG = (MODE != 1) ? 1 : 0;
            for (int it0 = gw; it0 < NIT; it0 += NGW) {
                int it = it0;
                if (tr_seg(it, f1in, 2 * FF, f1n, 1.f, W1in_t, DM, ON * 2 * FF, 1, scr, lane)) continue;
                if (tr_seg(it, f1out, DM, nullptr, 0.5f, W1out_t, FF, ON * DM, 0, scr, lane)) continue;
                if (tr_seg(it, win, NIN, mixn, 1.f, Win_t, DM, ON * 7 * DM, 2, scr, lane)) continue;
                if (tr_seg(it, wrnn, DM, nullptr, 1.f, Wr_t, DM, ON * DM, 0, scr, lane)) continue;
                if (tr_seg(it, watt, DM, nullptr, 1.f, Wat_t, DM, ON * DM, 0, scr, lane)) continue;
                if (tr_seg(it, wo, DM, nullptr, 1.f, Wo_t, DM, ON * DM, 0, scr, lane)) continue;
                if (tr_seg(it, f2in, 2 * FF, f2n, 1.f, W2in_t, DM, ON * 2 * FF, 1, scr, lane)) continue;
                if (tr_seg(it, f2out, DM, nullptr, 0.5f, W2out_t, FF, ON * DM, 0, scr, lane)) continue;
                if (tr_seg(it, plewg, DM, plen, 1.f, Wpg_t, DM, ONG * DM, 0, scr, lane)) continue;
                tr_seg(it, plewp, DM, nullptr, 1.f, Wpe_t, PLE, ON * DM, 0, scr, lane);
            }
            if (MODE != 2) {
            const float* rgwa = IN(I_RGWA) + (size_t)LL * 16 * 64 * 64; const float* rgwx = IN(I_RGWX) + (size_t)LL * 16 * 64 * 64;
            for (int e = gt; e < 2048 * 128; e += NGT) {
                const int Rr = e >> 7, kk = e & 127, pn = Rr >> 8, j = Rr & 255, c = 128 * pn + (j & 127), ic = 128 * pn + kk, blk = c >> 6;
                float v = 0.f; if ((ic >> 6) == blk) v = ((j >> 7) ? rgwx : rgwa)[((size_t)blk * 64 + (ic & 63)) * 64 + (c & 63)];
                Wg_t[e] = (bf16_t)(cvtpk(v, 0.f) & 0xffffu);
            }
            const float* lam = IN(I_RGLAM) + LL * DM;
            for (int e = gt; e < DM; e += NGT) sp8[e] = 8.f * log1pf(expf(-lam[e]));
            for (int e = gt; e < DM * 8; e += NGT) { const int k = e >> 3, h = e & 7; wfg[e] = mixn[k] * win[(size_t)k * NIN + 5120 + h]; }
            const float* pl = IN(I_P) + (size_t)LL * T * PLE;
            for (int e0 = gt; e0 < T * PLE / 8; e0 += 4 * NGT) { f32x4 pa[4], pq[4];
#pragma unroll
                for (int k = 0; k < 4; ++k) { const int e = e0 + k * NGT; if (e < T * PLE / 8) { pa[k] = *(const f32x4*)(pl + (size_t)e * 8); pq[k] = *(const f32x4*)(pl + (size_t)e * 8 + 4); } }
#pragma unroll
                for (int k = 0; k < 4; ++k) { const int e = e0 + k * NGT; if (e < T * PLE / 8) { u32x4 w; w.x = cvtpk(pa[k][0], pa[k][1]); w.y = cvtpk(pa[k][2], pa[k][3]); w.z = cvtpk(pq[k][0], pq[k][1]); w.w = cvtpk(pq[k][2], pq[k][3]); *(u32x4*)(pb + (size_t)e * 8) = w; } } }
            if (LL == 0) {
                const float* x0 = IN(I_X);
                for (int row = gw; row < T; row += NGW) {
                    const f32x4* xr = (const f32x4*)(x0 + (size_t)row * DM) + lane; float s = 0.f;
                    u32x2* o8 = (u32x2*)(xb2 + (size_t)row * DM) + lane;
#pragma unroll
                    for (int j = 0; j < 4; ++j) { const f32x4 v = xr[64 * j]; s += (v[0] * v[0] + v[1] * v[1]) + (v[2] * v[2] + v[3] * v[3]); u32x2 w; w.x = cvtpk(v[0], v[1]); w.y = cvtpk(v[2], v[3]); o8[64 * j] = w; }
                    s = wave_sum(s);
                    if (lane < 16) ssA[(size_t)row * 16 + lane] = lane == 0 ? s : 0.f;
                }
            }
        }
        }
}

template <int l> __device__ __forceinline__ void layer_body(const Params& P, LAS unsigned char* lds, unsigned char* lds_raw, cg::grid_group& grid, const int G0, const int bx0, const int vcu0) {
    pg8::StaticOrder SO;
        if (l == 0) { layer_prep<0, 0>(P, lds, G0, bx0, vcu0); GRID_SYNC(); }
#if PH(1)
        REP(2) { PHASE_PTRS pg8::Gemm g{xb2, W1in_t, T, 2 * FF, DM, DM, 0}; SO.init(T, 2 * FF, G, bx); pg8::EpiSwiGLU E{act, ssA};
          pg8::gemm_phase<pg8::EpiSwiGLU, true>(lds, g, SO, E); }
#endif
        if constexpr (l > 0) layer_prep<l, 2>(P, lds, G0, bx0, vcu0);
        GRID_SYNC();
#if PH(2)
#if PROBE == 8
        { PHASE_PTRS const float* xin0 = (l == 0) ? IN(I_X) : xres; pg8::Gemm g{act, W1out_t, T, DM, FF, FF, 0}; SO.init(T, DM, G, bx);
          pg8::EpiResid<false> E{xin0, (float*)(R + 2 * (size_t)T * DM * 2), R + 6 * (size_t)T * DM, agg, nullptr, nullptr, nullptr};
          pg8::gemm_phase<pg8::EpiResid<false>, true>(lds, g, SO, E); }
#endif
        { PHASE_PTRS const float* xin0 = (l == 0) ? IN(I_X) : xres; pg8::Gemm g{act, W1out_t, T, DM, FF, FF, 0}; SO.init(T, DM, G, bx); pg8::EpiResid<false> E{xin0, xres, xb, ssB, nullptr, nullptr, nullptr};
          pg8::gemm_phase<pg8::EpiResid<false>, true>(lds, g, SO, E); }
#endif
        GRID_SYNC();
#if PH(3)
        REP(6) { PHASE_PTRS pg8::Gemm g{xb, Win_t, T, 7 * DM, DM, DM, 0}; SO.init(T, 7 * DM, G, bx); pg8::EpiProj E{R, ssB, IN(I_QN) + l * HD, IN(I_KN) + l * HD, (LAS float*)(lds + 131072)};
          pg8::gemm_phase<pg8::EpiProj, true>(lds, g, SO, E); }
        REP(1) {
            PHASE_PTRS PHASE_IDS_
            LAS float* wl = (LAS float*)lds;
            __syncthreads();
            for (int e = tid; e < DM * 8; e += 512) wl[e] = wfg[e];
            __syncthreads();
            const float* fb = IN(I_FB) + l * NH;
            f32x4 xv[4];
            if (gw < T) { const f32x4* xr0 = (const f32x4*)(xres + (size_t)gw * DM) + lane;
#pragma unroll
                for (int j = 0; j < 4; ++j) xv[j] = xr0[64 * j]; }
            for (int row = gw; row < T; row += NGW) {
                float s = 0.f; float a8[8] = {0.f, 0.f, 0.f, 0.f, 0.f, 0.f, 0.f, 0.f};
                f32x4 xc4[4];
#pragma unroll
                for (int j = 0; j < 4; ++j) xc4[j] = xv[j];
                if (row + NGW < T) { const f32x4* xrn = (const f32x4*)(xres + (size_t)(row + NGW) * DM) + lane;
#pragma unroll
                    for (int j = 0; j < 4; ++j) xv[j] = xrn[64 * j]; }
#pragma unroll
                for (int j = 0; j < 4; ++j) { const f32x4 v = xc4[j]; s += (v[0] * v[0] + v[1] * v[1]) + (v[2] * v[2] + v[3] * v[3]);
#pragma unroll
                    for (int e = 0; e < 4; ++e) { const int k = 256 * j + 4 * lane + e; const f32x4 w0 = *(const LAS f32x4*)(wl + k * 8), w1 = *(const LAS f32x4*)(wl + k * 8 + 4);
                        a8[0] += v[e] * w0[0]; a8[1] += v[e] * w0[1]; a8[2] += v[e] * w0[2]; a8[3] += v[e] * w0[3]; a8[4] += v[e] * w1[0]; a8[5] += v[e] * w1[1]; a8[6] += v[e] * w1[2]; a8[7] += v[e] * w1[3]; } }
                s = wave_sum(s); const float r = rsqrtf(s * (1.f / DM) + EPS);
                float b4[4], c2[2], mine;
                { const bool up = lane & 1;
#pragma unroll
                  for (int i = 0; i < 4; ++i) { const float snd = up ? a8[i] : a8[4 + i], kp = up ? a8[4 + i] : a8[i]; b4[i] = kp + __shfl_xor(snd, 1); } }
                { const bool up = lane & 2;
#pragma unroll
                  for (int i = 0; i < 2; ++i) { const float snd = up ? b4[i] : b4[2 + i], kp = up ? b4[2 + i] : b4[i]; c2[i] = kp + __shfl_xor(snd, 2); } }
                { const bool up = lane & 4; const float snd = up ? c2[0] : c2[1], kp = up ? c2[1] : c2[0]; mine = kp + __shfl_xor(snd, 4); }
                mine += __shfl_xor(mine, 8); mine += __shfl_xor(mine, 16); mine += __shfl_xor(mine, 32);
                if (lane < 8) { const int hh = ((lane & 1) << 2) | (lane & 2) | ((lane >> 2) & 1);
                    const float z = mine * r + fb[hh]; const float lf = (z >= 0.f) ? -log1pf(expf(-z)) : z - log1pf(expf(z));
                    const int b = row / SEQ, t = row % SEQ; logf_[((size_t)(b * NH + hh)) * SEQ + t] = lf; }
            }
        }
#endif
        GRID_SYNC();
#if PH(4)
        {
            PHASE_PTRS PHASE_IDS_
            const float* cw = IN(I_CONVW) + (size_t)l * 4 * DM; const float* cb = IN(I_CONVB) + l * DM;
            REP(1) for (int task = gt; task < (T / 16) * 128; task += NGT) {
                const int cgp = task & 127, run = task >> 7, c0 = cgp * 8, t0 = run * 16;
                float w[4][8], bb[8];
#pragma unroll
                for (int k = 0; k < 4; ++k) { const f32x4 a = *(const f32x4*)(cw + k * DM + c0), b = *(const f32x4*)(cw + k * DM + c0 + 4);
                    w[k][0] = a[0]; w[k][1] = a[1]; w[k][2] = a[2]; w[k][3] = a[3]; w[k][4] = b[0]; w[k][5] = b[1]; w[k][6] = b[2]; w[k][7] = b[3]; }
                { const f32x4 a = *(const f32x4*)(cb + c0), b = *(const f32x4*)(cb + c0 + 4); bb[0] = a[0]; bb[1] = a[1]; bb[2] = a[2]; bb[3] = a[3]; bb[4] = b[0]; bb[5] = b[1]; bb[6] = b[2]; bb[7] = b[3]; }
                float h0[8], h1[8], h2[8];
                const bool first = (t0 % SEQ) == 0;
                u32x4 z = {0u, 0u, 0u, 0u};
                u32x4 r0 = first ? z : *(const u32x4*)(b_rx + (size_t)(t0 - 3) * DM + c0), r1 = first ? z : *(const u32x4*)(b_rx + (size_t)(t0 - 2) * DM + c0), r2 = first ? z : *(const u32x4*)(b_rx + (size_t)(t0 - 1) * DM + c0);
#define UNP(dst, rr) do { dst[0] = bflo(rr.x); dst[1] = bfhi(rr.x); dst[2] = bflo(rr.y); dst[3] = bfhi(rr.y); dst[4] = bflo(rr.z); dst[5] = bfhi(rr.z); dst[6] = bflo(rr.w); dst[7] = bfhi(rr.w); } while (0)
                UNP(h0, r0); UNP(h1, r1); UNP(h2, r2);
#pragma unroll
                for (int i = 0; i < 16; ++i) {
                    const u32x4 rc = *(const u32x4*)(b_rx + (size_t)(t0 + i) * DM + c0); float h3[8]; UNP(h3, rc); float y[8];
#pragma unroll
                    for (int j = 0; j < 8; ++j) { y[j] = bb[j] + w[0][j] * h0[j] + w[1][j] * h1[j] + w[2][j] * h2[j] + w[3][j] * h3[j]; h0[j] = h1[j]; h1[j] = h2[j]; h2[j] = h3[j]; }
                    u32x4 o; o.x = cvtpk(y[0], y[1]); o.y = cvtpk(y[2], y[3]); o.z = cvtpk(y[4], y[5]); o.w = cvtpk(y[6], y[7]);
                    *(u32x4*)(b_rxc + (size_t)(t0 + i) * DM + c0) = o;
                }
            }
#undef UNP
            if (gt == 0) *(unsigned*)(ws + WS_VEC + 262144) = 0u;
            if (vcu < NB * NH) {
                LAS float* wsum = (LAS float*)lds;
                const float* src = logf_ + (size_t)vcu * SEQ + tid * 16; float v[16];
#pragma unroll
                for (int j = 0; j < 4; ++j) { const f32x4 a = *(const f32x4*)(src + 4 * j); v[4 * j] = a[0]; v[4 * j + 1] = a[1]; v[4 * j + 2] = a[2]; v[4 * j + 3] = a[3]; }
#pragma unroll
                for (int j = 1; j < 16; ++j) v[j] += v[j - 1];
                float incl = v[15];
#pragma unroll
                for (int o = 1; o < 64; o <<= 1) { const float n = __shfl_up(incl, o); if (lane >= o) incl += n; }
                __syncthreads();
                if (lane == 63) wsum[wave] = incl;
                __syncthreads();
                float basev = incl - v[15];
                for (int w = 0; w < wave; ++w) basev += wsum[w];
                float* dst = nd2 + (size_t)vcu * SEQ + tid * 16;
#pragma unroll
                for (int j = 0; j < 4; ++j) { f32x4 o; o[0] = -LOG2E * (basev + v[4 * j]); o[1] = -LOG2E * (basev + v[4 * j + 1]); o[2] = -LOG2E * (basev + v[4 * j + 2]); o[3] = -LOG2E * (basev + v[4 * j + 3]); *(f32x4*)(dst + 4 * j) = o; }
                __syncthreads();
            }
        }
#endif
        GRID_SYNC();
#if PH(5)
        REP(5) { PHASE_PTRS pg8::Gemm g{b_rxc, Wg_t, T, 2 * DM, 128, DM, 128}; SO.init(T, 2 * DM, G, bx);
          pg8::EpiGate E{b_rxc, b_L, b_U, IN(I_RGBA) + l * DM, IN(I_RGBX) + l * DM, sp8};
          pg8::gemm_phase<pg8::EpiGate, true>(lds, g, SO, E); }
#endif
#if PH(13)
        { PHASE_PTRS __syncthreads();
        att::attn_phase((char*)lds_raw, (const att::bf16*)b_q, (const att::bf16*)b_k, (const att::bf16*)b_v, (att::bf16*)b_q, nd2, (unsigned*)(ws + WS_VEC + 262144), IN(I_QN) + l * HD, IN(I_KN) + l * HD); }
#endif
        GRID_SYNC();
#if PH(6)
        REP(1) { PHASE_PTRS PHASE_IDS_
        for (int task = gt; task < NB * 64 * 512; task += NGT) {
            const int cp = task & 511, ch = (task >> 9) & 63, b = task >> 15; const size_t base = ((size_t)b * SEQ + (size_t)ch * 128) * DM + cp * 2;
            float A0 = 1.f, A1 = 1.f, H0 = 0.f, H1 = 0.f;
#pragma unroll 16
            for (int i = 0; i < 128; ++i) { const unsigned lw = *(const unsigned*)(b_L + base + (size_t)i * DM), uw = *(const unsigned*)(b_U + base + (size_t)i * DM);
                const float a0 = __builtin_amdgcn_exp2f(bflo(lw) * LOG2E), a1 = __builtin_amdgcn_exp2f(bfhi(lw) * LOG2E);
                A0 *= a0; A1 *= a1; H0 = a0 * H0 + bflo(uw); H1 = a1 * H1 + bfhi(uw); }
            f32x4 o = {A0, H0, A1, H1}; *(f32x4*)(agg + ((size_t)(b * 64 + ch) * DM + cp * 2) * 2) = o;
        } }
#endif
        GRID_SYNC();
#if PH(7)
        REP(1) { PHASE_PTRS PHASE_IDS_
        for (int task = gt; task < NB * 64 * 512; task += NGT) {
            const int cp = task & 511, ch = (task >> 9) & 63, b = task >> 15; const size_t base = ((size_t)b * SEQ + (size_t)ch * 128) * DM + cp * 2;
            float H0 = 0.f, H1 = 0.f;
            for (int j = 0; j < ch; j += 8) {
                f32x4 ag[8];
#pragma unroll
                for (int k = 0; k < 8; ++k) { const int jj = (j + k < ch) ? j + k : j; ag[k] = *(const f32x4*)(agg + ((size_t)(b * 64 + jj) * DM + cp * 2) * 2); }
#pragma unroll
                for (int k = 0; k < 8; ++k) if (j + k < ch) { H0 = ag[k][0] * H0 + ag[k][1]; H1 = ag[k][2] * H1 + ag[k][3]; }
            }
            for (int i0 = 0; i0 < 128; i0 += 16) {
                unsigned lw[16], uw[16], gv[16];
#pragma unroll
                for (int k = 0; k < 16; ++k) { const size_t off = base + (size_t)(i0 + k) * DM; lw[k] = *(const unsigned*)(b_L + off); uw[k] = *(const unsigned*)(b_U + off); gv[k] = *(const unsigned*)(b_rgate + off); }
#pragma unroll
                for (int k = 0; k < 16; ++k) { const size_t off = base + (size_t)(i0 + k) * DM;
                    const float a0 = __builtin_amdgcn_exp2f(bflo(lw[k]) * LOG2E), a1 = __builtin_amdgcn_exp2f(bfhi(lw[k]) * LOG2E);
                    H0 = a0 * H0 + bflo(uw[k]); H1 = a1 * H1 + bfhi(uw[k]);
                    *(unsigned*)(b_ya + off) = cvtpk(H0 * gelu_tanh(bflo(gv[k])), H1 * gelu_tanh(bfhi(gv[k]))); }
            }
        } }
#endif
        GRID_SYNC();
#if PH(8)
        REP(4) {
          { PHASE_PTRS const float* mb = IN(I_MERGEB) + l * 2 * DM; pg8::Gemm g{b_ya, Wr_t, T, DM, DM, DM, 0}; SO.init(T, DM, G, bx); pg8::EpiMerge<false> E{b_ga, mb, nullptr, b_mrg};
            pg8::gemm_phase<pg8::EpiMerge<false>, true>(lds, g, SO, E); }
          { PHASE_PTRS const float* mb = IN(I_MERGEB) + l * 2 * DM; pg8::Gemm g{b_q, Wat_t, T, DM, DM, DM, 0}; SO.init(T, DM, G, bx); pg8::EpiMerge<true> E{b_gb, mb + DM, b_mrg, b_mrg};
            pg8::gemm_phase<pg8::EpiMerge<true>, true>(lds, g, SO, E); } }
#endif
        GRID_SYNC();
#if PH(9)
        { PHASE_PTRS pg8::Gemm g{b_mrg, Wo_t, T, DM, DM, DM, 0}; SO.init(T, DM, G, bx); pg8::EpiResid<false> E{xres, xres, xb, ssA, nullptr, nullptr, nullptr};
          pg8::gemm_phase<pg8::EpiResid<false>, true>(lds, g, SO, E); }
#endif
        GRID_SYNC();
#if PH(10)
        { PHASE_PTRS pg8::Gemm g{xb, W2in_t, T, 2 * FF, DM, DM, 0}; SO.init(T, 2 * FF, G, bx); pg8::EpiSwiGLU E{act, ssA};
          pg8::gemm_phase<pg8::EpiSwiGLU, true>(lds, g, SO, E); }
        { PHASE_PTRS pg8::Gemm g{pb, Wpe_t, T, DM, PLE, PLE, 0}; SO.init(T, DM, G, bx); pg8::EpiPlain E{b_E};
          pg8::gemm_phase<pg8::EpiPlain, true>(lds, g, SO, E); }
#endif
        GRID_SYNC();
#if PH(11)
        { PHASE_PTRS pg8::Gemm g{act, W2out_t, T, DM, FF, FF, 0}; SO.init(T, DM, G, bx); pg8::EpiResid<false> E{xres, xres, xb, ssB, nullptr, nullptr, nullptr};
          pg8::gemm_phase<pg8::EpiResid<false>, true>(lds, g, SO, E); }
#endif
        GRID_SYNC();
#if PH(12)
        { PHASE_PTRS pg8::Gemm g{xb, Wpg_t, T, DM, DM, DM, 0}; SO.init(T, DM, G, bx); pg8::EpiResid<true> E{xres, xres, xb2, ssA, ssB, IN(I_PLEBG) + l * DM, b_E};
          pg8::gemm_phase<pg8::EpiResid<true>, true>(lds, g, SO, E); }
#endif
        if constexpr (l < NL - 1) layer_prep<l + 1, 1>(P, lds, G0, bx0, vcu0);
        GRID_SYNC();
}

__global__ void __launch_bounds__(512, 2) fwd_kernel(Params P) {
    extern __shared__ __attribute__((aligned(16))) unsigned char lds_raw[];
    LAS unsigned char* lds = (LAS unsigned char*)lds_raw;
    cg::grid_group grid = cg::this_grid();
    const int G0 = gridDim.x, bx0 = blockIdx.x;
    const int vcu0 = (G0 % 8 == 0) ? (bx0 % 8) * (G0 / 8) + bx0 / 8 : bx0;
    if (threadIdx.x < 2) ((volatile LAS unsigned*)(lds + LDS_BARST))[threadIdx.x] = 0u;
    if (threadIdx.x == 0) (void)xb_add((unsigned*)(P.ws + WS_BAR) + XB_XCNT(xb_xcc_id()), 1u);
    __syncthreads();
    if (P.ws == nullptr) grid.sync();
    layer_body<0>(P, lds, lds_raw, grid, G0, bx0, vcu0);
    layer_body<1>(P, lds, lds_raw, grid, G0, bx0, vcu0);
    layer_body<2>(P, lds, lds_raw, grid, G0, bx0, vcu0);
    layer_body<3>(P, lds, lds_raw, grid, G0, bx0, vcu0);
    {
        PHASE_PTRS PHASE_IDS_
        const float* gf = IN(I_FINALN);
        f32x4 nv[4];
        if (gw < T) { const f32x4* xr0 = (const f32x4*)(xres + (size_t)gw * DM) + lane;
#pragma unroll
            for (int j = 0; j < 4; ++j) nv[j] = xr0[64 * j]; }
        for (int row = gw; row < T; row += NGW) {
            f32x4* xr = (f32x4*)(xres + (size_t)row * DM) + lane; f32x4 v[4]; float s = 0.f;
#pragma unroll
            for (int j = 0; j < 4; ++j) v[j] = nv[j];
            if (row + NGW < T) { const f32x4* xrn = (const f32x4*)(xres + (size_t)(row + NGW) * DM) + lane;
#pragma unroll
                for (int j = 0; j < 4; ++j) nv[j] = xrn[64 * j]; }
#pragma unroll
            for (int j = 0; j < 4; ++j) { s += (v[j][0] * v[j][0] + v[j][1] * v[j][1]) + (v[j][2] * v[j][2] + v[j][3] * v[j][3]); }
            s = wave_sum(s); const float r = rsqrtf(s * (1.f / DM) + EPS);
#pragma unroll
            for (int j = 0; j < 4; ++j) { const f32x4 gv = *((const f32x4*)gf + lane + 64 * j); xr[64 * j] = v[j] * r * gv; }
        }
    }
}

extern "C" void kernel_launch(void* const* d_in, const int* in_sizes, int n_in, void* d_out, int out_size, void* d_ws, size_t ws_size, hipStream_t stream) {
    static int grid = 0;
    if (grid == 0) {
        if (n_in != 29 || out_size != T * DM || ws_size < WS_END) { fprintf(stderr, "kernel_launch: unexpected problem (n_in %d out %d ws %zu)\n", n_in, out_size, ws_size); grid = -1; return; }
        int dev = 0, cus = 0, per_cu = 0;
        (void)hipGetDevice(&dev); (void)hipDeviceGetAttribute(&cus, hipDeviceAttributeMultiprocessorCount, dev);
        (void)hipFuncSetAttribute((const void*)fwd_kernel, hipFuncAttributeMaxDynamicSharedMemorySize, LDS_BYTES);
        (void)hipOccupancyMaxActiveBlocksPerMultiprocessor(&per_cu, (const void*)fwd_kernel, 512, LDS_BYTES);
        if (cus <= 0) cus = 256;
        grid = cus;
        if (per_cu < 1) fprintf(stderr, "kernel_launch: occupancy query reports %d workgroups per CU\n", per_cu);
        (void)hipGetLastError();
    }
    if (grid < 0) return;
    if (hipMemsetAsync((char*)d_ws + WS_BAR, 0, XCD_BAR_WORDS * 4, stream) != hipSuccess) { fprintf(stderr, "kernel_launch: memset failed\n"); return; }
    Params p{};
    for (int i = 0; i < 29; ++i) p.in[i] = (const float*)d_in[i];
    p.out = (float*)d_out; p.ws = (unsigned char*)d_ws;
    void* args[] = {&p};
    hipError_t e = hipLaunchCooperativeKernel((const void*)fwd_kernel, dim3(grid), dim3(512), args, LDS_BYTES, stream);
    if (e != hipSuccess) fprintf(stderr, "cooperative launch failed: %s (grid %d)\n", hipGetErrorString(e), grid);
}
```

```cpp
#include <hip/hip_runtime.h>
#include <hip/hip_cooperative_groups.h>
#include <hip/hip_bf16.h>
#include <cstdio>
#include <cstdint>
namespace cg = cooperative_groups;

#ifndef PROBE
#define PROBE 0
#endif
#define LAS __attribute__((address_space(3)))
typedef unsigned short bf16_t;
typedef short bf16x8 __attribute__((ext_vector_type(8)));
typedef short s16x4 __attribute__((ext_vector_type(4)));
typedef float f32x4 __attribute__((ext_vector_type(4)));
typedef float f32x16 __attribute__((ext_vector_type(16)));
typedef unsigned u32x4 __attribute__((ext_vector_type(4)));
typedef unsigned u32x2 __attribute__((ext_vector_type(2)));

constexpr int NB = 4, SEQ = 8192, T = NB * SEQ, DM = 1024, FF = 2816, NH = 8, HD = 128, NL = 4, PLE = 256, NIN = 7176;
constexpr float EPS = 1e-6f;
constexpr float LOG2E = 1.4426950408889634f;

constexpr size_t MiB = 1u << 20;
constexpr size_t WS_SS0 = 0, WS_SS1 = 2 * MiB, WS_LOGF = 4 * MiB, WS_ND2 = 5 * MiB, WS_AGG = 6 * MiB, WS_VEC = 8 * MiB;
constexpr size_t WS_W1IN = 16 * MiB, WS_W1OUT = 27 * MiB, WS_WIN = 33 * MiB, WS_WG = 47 * MiB, WS_WR = 48 * MiB, WS_WAT = 50 * MiB, WS_WO = 52 * MiB,
                 WS_W2IN = 54 * MiB, WS_W2OUT = 65 * MiB, WS_WPG = 71 * MiB, WS_WPE = 73 * MiB;
constexpr size_t WS_XB = 80 * MiB, WS_PB = 144 * MiB, WS_R = 160 * MiB, WS_X1 = 608 * MiB, WS_END = 672 * MiB;
constexpr size_t BUF = 64 * MiB;
constexpr int LDS_BYTES = 147456;

__device__ __forceinline__ unsigned cvtpk(float lo, float hi) { unsigned r; asm volatile("v_cvt_pk_bf16_f32 %0, %1, %2" : "=v"(r) : "v"(lo), "v"(hi)); return r; }
__device__ __forceinline__ float bflo(unsigned u) { return __uint_as_float(u << 16); }
__device__ __forceinline__ float bfhi(unsigned u) { return __uint_as_float(u & 0xffff0000u); }
__device__ __forceinline__ float sigmoidf_(float x) { return __builtin_amdgcn_rcpf(1.f + __builtin_amdgcn_exp2f(-x * LOG2E)); }
__device__ __forceinline__ float gelu_tanh(float x) { const float u2 = 1.5957691216f * (x + 0.044715f * x * x * x); return x * sigmoidf_(u2); }
__device__ __forceinline__ float row_rstd(const float* ss, int row) {
    const f32x4* p = (const f32x4*)(ss + (size_t)row * 16);
    const f32x4 a = p[0], b = p[1], c = p[2], d = p[3];
    const float s = ((a[0] + a[1]) + (a[2] + a[3])) + ((b[0] + b[1]) + (b[2] + b[3])) + ((c[0] + c[1]) + (c[2] + c[3])) + ((d[0] + d[1]) + (d[2] + d[3]));
    return rsqrtf(s * (1.f / 1024.f) + EPS);
}
#define LDS_WAIT() asm volatile("s_waitcnt lgkmcnt(0)" ::: "memory")

namespace pg8 {
constexpr int BM = 256, BK = 64, HALF = 128, HTB = HALF * BK * 2, STAGE_BYTES = 8 * HTB, NXCD = 8, WGM = 8;
__host__ __device__ __forceinline__ int lds_byte(int r, int c) { const int st = (r >> 4) * 2 + (c >> 5), rr = r & 15, cc = c & 31, ob = rr * 64 + cc * 2; return st * 1024 + (ob ^ (((ob >> 9) & 1) << 5)); }
__host__ __device__ __forceinline__ void stage_rc(int b, int& R, int& C) { const int st = b / 1024, sb = b % 1024, swz = sb ^ (((sb >> 9) & 1) << 5); R = (st >> 1) * 16 + swz / 64; C = (st & 1) * 32 + (swz % 64) / 2; }
__host__ __device__ __forceinline__ int perm32(int rho) { const int n = rho >> 4, i = rho & 15; return 8 * (i >> 2) + 4 * n + (i & 3); }
struct Unit { int pm, pn; };
struct Gemm { const bf16_t* A; const bf16_t* Bt; int M, N, K; int lda; int a_pn_off; };
struct StaticOrder {
    int nM, nN, nwg, G, c;
    __device__ void init(int M, int N, int G_, int c_) { nM = M / BM; nN = N / BM; nwg = nM * nN; G = G_; c = c_; }
    __device__ bool next(int i, Unit& u) const {
        const long L = (long)i * G + c; if (L >= nwg) return false;
        int wgid = (int)L; { const int q = nwg / NXCD, r = nwg % NXCD, xcd = wgid % NXCD, off = wgid / NXCD; wgid = (xcd < r ? xcd * (q + 1) : r * (q + 1) + (xcd - r) * q) + off; }
        const int nig = WGM * nN, gid = wgid / nig, fm = gid * WGM, gsz = (nM - fm) < WGM ? (nM - fm) : WGM;
        u.pm = fm + ((wgid % nig) % gsz); u.pn = (wgid % nig) / gsz; return true;
    }
};

constexpr int RSTD_TBL_OFF = 131072 + 8192;
__device__ __forceinline__ void rstd_prep(const float* ss, int pm, int& prev_pm, int& tb, LAS float* tbl, int tid) {
    if (pm == prev_pm) return;
    tb ^= 1; prev_pm = pm;
    if (tid < 256) tbl[tb * 256 + tid] = row_rstd(ss, pm * 256 + tid);
}
typedef f32x4 Acc[2][2][4][2];
__device__ __forceinline__ void zero_acc(Acc& acc) {
#pragma unroll
    for (int a = 0; a < 2; ++a)
#pragma unroll
        for (int b = 0; b < 2; ++b)
#pragma unroll
            for (int m = 0; m < 4; ++m)
#pragma unroll
                for (int n = 0; n < 2; ++n) acc[a][b][m][n] = (f32x4){0.f, 0.f, 0.f, 0.f};
}
template <class Epi, bool ALIGN_EPI>
__device__ __forceinline__ void gemm_phase(LAS unsigned char* lds, const Gemm g, const StaticOrder& S, const Epi& E) {
    int tid = threadIdx.x; asm volatile("" : "+v"(tid));
    const int wid = __builtin_amdgcn_readfirstlane(tid >> 6), lane = tid & 63, wr = wid >> 2, wc = wid & 3, fr = lane & 15, fq = lane >> 4;
    const int K = g.K, nt = K / BK;
    unsigned voffA[2], voffB[2];
#pragma unroll
    for (int i = 0; i < 2; ++i) { int R, C; stage_rc(tid * 16 + i * 8192, R, C); const int Rb = Epi::PERM ? ((R & ~31) + perm32(R & 31)) : R;
        voffA[i] = (unsigned)(R * g.lda + C) * 2u; voffB[i] = (unsigned)(Rb * K + C) * 2u; }
    const size_t kstep = (size_t)(BK * 2);
    const size_t hstepA = (size_t)HALF * g.lda * 2, hstepB = (size_t)HALF * K * 2;
    const size_t tstepA = 2 * hstepA, tstepB = 2 * hstepB;
    const size_t pnoffA = (size_t)g.a_pn_off * 2;
    const unsigned ldsw = (unsigned)wid * 1024u;
    const int aoff = lds_byte(wr * 64 + fr, fq * 8), boff = lds_byte(wc * 32 + fr, fq * 8);
#define PG8_SA(b, h) (((b) * 2 + (h)) * HTB)
#define PG8_SB(b, h) ((4 + (b) * 2 + (h)) * HTB)
#define PG8_STAGE(bufoff, gbase, voff) do { _Pragma("unroll") for (int _i = 0; _i < 2; ++_i) \
        __builtin_amdgcn_global_load_lds((const unsigned*)((const char*)(gbase) + (voff)[_i]), (LAS unsigned*)(lds + (bufoff) + ldsw + _i * 8192), 16, 0, 0); } while (0)
#define PG8_LDA(dst, b, h) do { _Pragma("unroll") for (int m = 0; m < 4; ++m) _Pragma("unroll") for (int k = 0; k < 2; ++k) dst[m][k] = *(const LAS bf16x8*)(lds + PG8_SA(b, h) + aoff + m * 2048 + k * 1024); } while (0)
#define PG8_LDB(dst, b, h) do { _Pragma("unroll") for (int n = 0; n < 2; ++n) _Pragma("unroll") for (int k = 0; k < 2; ++k) dst[n][k] = *(const LAS bf16x8*)(lds + PG8_SB(b, h) + boff + n * 2048 + k * 1024); } while (0)
#define PG8_MMA(ai, bj, At, Bt) do { __builtin_amdgcn_s_setprio(1); _Pragma("unroll") for (int m = 0; m < 4; ++m) _Pragma("unroll") for (int n = 0; n < 2; ++n) _Pragma("unroll") for (int k = 0; k < 2; ++k) \
        acc[ai][bj][m][n] = __builtin_amdgcn_mfma_f32_16x16x32_bf16(Bt[n][k], At[m][k], acc[ai][bj][m][n], 0, 0, 0); __builtin_amdgcn_s_setprio(0); } while (0)
#define PG8_WAIT_V(n) asm volatile("s_waitcnt vmcnt(" #n ")" ::: "memory")
#define PG8_WAIT_L(n) asm volatile("s_waitcnt lgkmcnt(" #n ")" ::: "memory")
#define PG8_BAR __builtin_amdgcn_s_barrier()
#define PG8_SCHED __builtin_amdgcn_sched_barrier(0)
    Unit cur, nxt; int ui = 0;
    if (!S.next(0, cur)) return;
    f32x4 acc[2][2][4][2];
    E.init(acc, cur, wr, wc, fr, fq);
    int prev_pm = -1, tb = 0;
    E.prep(cur.pm, prev_pm, tb, (LAS float*)(lds + RSTD_TBL_OFF), tid);
    bf16x8 At[4][2], B0[2][2], B1[2][2];
    const char* cA = (const char*)g.A + (size_t)cur.pm * tstepA + (size_t)cur.pn * pnoffA; const char* cB = (const char*)g.Bt + (size_t)cur.pn * tstepB;
    PG8_STAGE(PG8_SB(0, 0), cB, voffB); PG8_STAGE(PG8_SB(0, 1), cB + hstepB, voffB); PG8_STAGE(PG8_SA(0, 0), cA, voffA); PG8_STAGE(PG8_SA(0, 1), cA + hstepA, voffA);
    if (wr == 1) PG8_BAR;
    PG8_WAIT_V(2); PG8_BAR;
    PG8_STAGE(PG8_SB(1, 0), cB + kstep, voffB); PG8_STAGE(PG8_SA(1, 0), cA + kstep, voffA); PG8_STAGE(PG8_SB(1, 1), cB + hstepB + kstep, voffB);
    PG8_WAIT_V(6); PG8_BAR;
    for (;;) {
        const bool has_next = S.next(ui + 1, nxt);
        const char* nA = has_next ? (const char*)g.A + (size_t)nxt.pm * tstepA + (size_t)nxt.pn * pnoffA : cA; const char* nB = has_next ? (const char*)g.Bt + (size_t)nxt.pn * tstepB : cB;
        for (int t = 0; t < nt; t += 2) {
            const bool last = (t == nt - 2);
            const char* a1 = cA + (size_t)(t + 1) * kstep;
            const char* a2 = last ? nA : cA + (size_t)(t + 2) * kstep; const char* b2 = last ? nB : cB + (size_t)(t + 2) * kstep;
            const char* a3 = a2 + kstep; const char* b3 = b2 + kstep;
            PG8_LDB(B0, 0, 0); PG8_LDB(B1, 0, 1); PG8_SCHED; PG8_LDA(At, 0, 0); PG8_STAGE(PG8_SA(1, 1), a1 + hstepA, voffA);
            PG8_WAIT_V(8); PG8_WAIT_L(0); PG8_BAR; PG8_MMA(0, 0, At, B0); PG8_MMA(0, 1, At, B1); PG8_BAR; PG8_SCHED;
            PG8_LDA(At, 0, 1); PG8_STAGE(PG8_SB(0, 0), b2, voffB); PG8_STAGE(PG8_SB(0, 1), b2 + hstepB, voffB); PG8_STAGE(PG8_SA(0, 0), a2, voffA);
            PG8_WAIT_V(8); PG8_WAIT_L(0); PG8_BAR; PG8_MMA(1, 0, At, B0); PG8_MMA(1, 1, At, B1); PG8_BAR; PG8_SCHED;
            PG8_LDB(B0, 1, 0); PG8_LDB(B1, 1, 1); PG8_SCHED; PG8_LDA(At, 1, 0); PG8_STAGE(PG8_SA(0, 1), a2 + hstepA, voffA);
            PG8_WAIT_V(8); PG8_WAIT_L(0); PG8_BAR; PG8_MMA(0, 0, At, B0); PG8_MMA(0, 1, At, B1); PG8_BAR; PG8_SCHED;
            PG8_LDA(At, 1, 1); PG8_STAGE(PG8_SB(1, 0), b3, voffB); PG8_STAGE(PG8_SB(1, 1), b3 + hstepB, voffB); PG8_STAGE(PG8_SA(1, 0), a3, voffA);
            PG8_WAIT_V(8); PG8_WAIT_L(0); PG8_BAR; PG8_MMA(1, 0, At, B0); PG8_MMA(1, 1, At, B1); PG8_BAR; PG8_SCHED;
        }
        if constexpr (ALIGN_EPI) { if (wr == 0) PG8_BAR; }
        E(acc, cur, wr, wc, fr, fq, (const LAS float*)(lds + RSTD_TBL_OFF) + tb * 256);
        if (!has_next) break;
        E.init(acc, nxt, wr, wc, fr, fq);
        E.prep(nxt.pm, prev_pm, tb, (LAS float*)(lds + RSTD_TBL_OFF), tid);
        cur = nxt; cA = nA; cB = nB; ++ui;
        if constexpr (ALIGN_EPI) { if (wr == 1) PG8_BAR; }
    }
    PG8_WAIT_V(0);
    if constexpr (!ALIGN_EPI) { if (wr == 0) PG8_BAR; }
    PG8_BAR;
#undef PG8_SA
#undef PG8_SB
#undef PG8_STAGE
#undef PG8_LDA
#undef PG8_LDB
#undef PG8_MMA
#undef PG8_WAIT_V
#undef PG8_WAIT_L
#undef PG8_BAR
#undef PG8_SCHED
}


struct EpiSwiGLU {
    static constexpr bool PERM = true;
    __device__ __forceinline__ void init(Acc& acc, const Unit&, int, int, int, int) const { zero_acc(acc); }
    __device__ __forceinline__ void prep(int pm, int& prev_pm, int& tb, LAS float* tbl, int tid) const { rstd_prep(ss, pm, prev_pm, tb, tbl, tid); }
    bf16_t* O; const float* ss;
    __device__ __forceinline__ void operator()(const Acc& acc, const Unit& u, int wr, int wc, int fr, int fq, const LAS float* rt) const {
        const int row0 = u.pm * BM + wr * 64 + fr, col0 = u.pn * 128 + wc * 32 + 8 * fq;
#pragma unroll
        for (int ai = 0; ai < 2; ++ai)
#pragma unroll
            for (int m = 0; m < 4; ++m) {
                const int row = row0 + ai * HALF + m * 16; const float r = rt[ai * HALF + wr * 64 + m * 16 + fr];
                float h[8];
#pragma unroll
                for (int n = 0; n < 2; ++n)
#pragma unroll
                    for (int e = 0; e < 4; ++e) { const float gg = acc[ai][0][m][n][e] * r, uu = acc[ai][1][m][n][e] * r; h[n * 4 + e] = gg * sigmoidf_(gg) * uu; }
                u32x4 w; w.x = cvtpk(h[0], h[1]); w.y = cvtpk(h[2], h[3]); w.z = cvtpk(h[4], h[5]); w.w = cvtpk(h[6], h[7]);
                __builtin_nontemporal_store(w, (u32x4*)(O + (size_t)row * FF + col0));
            }
    }
};
template <bool GATE> struct EpiResid {
    static constexpr bool PERM = false;
    const float* xin; float* xout; bf16_t* xb; float* ss_out; const float* ss_in; const float* bias; const bf16_t* Eb;
    __device__ __forceinline__ void prep(int pm, int& prev_pm, int& tb, LAS float* tbl, int tid) const { if (GATE) rstd_prep(ss_in, pm, prev_pm, tb, tbl, tid); }
    __device__ __forceinline__ void init(Acc& acc, const Unit& u, int wr, int wc, int fr, int fq) const {
        if (GATE) { zero_acc(acc); return; }
        const float* base = xin + (size_t)(u.pm * BM + wr * 64 + fr) * DM + u.pn * BM + wc * 32 + 4 * fq;
#pragma unroll
        for (int ai = 0; ai < 2; ++ai)
#pragma unroll
            for (int m = 0; m < 4; ++m)
#pragma unroll
                for (int bj = 0; bj < 2; ++bj)
#pragma unroll
                    for (int n = 0; n < 2; ++n) acc[ai][bj][m][n] = *(const f32x4*)(base + (size_t)(ai * HALF + m * 16) * DM + bj * HALF + n * 16);
    }
    __device__ __forceinline__ void operator()(const Acc& acc, const Unit& u, int wr, int wc, int fr, int fq, const LAS float* rt) const {
        const int row0 = u.pm * BM + wr * 64 + fr, col0 = u.pn * BM + wc * 32 + 4 * fq;
        f32x4 bvs[4];
        if (GATE) {
#pragma unroll
            for (int q = 0; q < 4; ++q) bvs[q] = *(const f32x4*)(bias + col0 + (q >> 1) * HALF + (q & 1) * 16);
        }
#pragma unroll
        for (int ai = 0; ai < 2; ++ai)
#pragma unroll
            for (int mp = 0; mp < 2; ++mp) {
                f32x4 xis[8]; u32x2 ebs[8];
                if (GATE) {
#pragma unroll
                    for (int k = 0; k < 8; ++k) { const size_t off = (size_t)(row0 + ai * HALF + (2 * mp + (k >> 2)) * 16) * DM + col0 + ((k >> 1) & 1) * HALF + (k & 1) * 16;
                        xis[k] = *(const f32x4*)(xin + off); ebs[k] = *(const u32x2*)(Eb + off); }
                }
#pragma unroll
                for (int mm = 0; mm < 2; ++mm) {
                    const int m = 2 * mp + mm; const int row = row0 + ai * HALF + m * 16; float r = 0.f; if (GATE) r = rt[ai * HALF + wr * 64 + m * 16 + fr];
                    float sq = 0.f;
#pragma unroll
                    for (int bj = 0; bj < 2; ++bj)
#pragma unroll
                        for (int n = 0; n < 2; ++n) {
                            const int c = col0 + bj * HALF + n * 16; const size_t off = (size_t)row * DM + c;
                            const f32x4 a = acc[ai][bj][m][n]; f32x4 xo;
                            if (GATE) { const int k = mm * 4 + bj * 2 + n; const f32x4 xi = xis[k]; const f32x4 bv = bvs[bj * 2 + n]; const u32x2 eb = ebs[k];
                                xo[0] = xi[0] + sigmoidf_(a[0] * r + bv[0]) * bflo(eb.x); xo[1] = xi[1] + sigmoidf_(a[1] * r + bv[1]) * bfhi(eb.x);
                                xo[2] = xi[2] + sigmoidf_(a[2] * r + bv[2]) * bflo(eb.y); xo[3] = xi[3] + sigmoidf_(a[3] * r + bv[3]) * bfhi(eb.y); }
                            else xo = a;
                            __builtin_nontemporal_store(xo, (f32x4*)(xout + off));
                            u32x2 w; w.x = cvtpk(xo[0], xo[1]); w.y = cvtpk(xo[2], xo[3]); *(u32x2*)(xb + off) = w;
                            sq += (xo[0] * xo[0] + xo[1] * xo[1]) + (xo[2] * xo[2] + xo[3] * xo[3]);
                        }
                    sq += __shfl_xor(sq, 16); sq += __shfl_xor(sq, 32);
                    if (fq == 0) ss_out[(size_t)row * 16 + u.pn * 4 + wc] = sq;
                }
            }
    }
};
struct EpiProj {
    static constexpr bool PERM = true;
    __device__ __forceinline__ void init(Acc& acc, const Unit&, int, int, int, int) const { zero_acc(acc); }
    __device__ __forceinline__ void prep(int pm, int& prev_pm, int& tb, LAS float* tbl, int tid) const { rstd_prep(ss, pm, prev_pm, tb, tbl, tid); }
    bf16_t* O; const float* ss; const float* qn; const float* kn; LAS float* P;
    __device__ __forceinline__ void operator()(const Acc& acc, const Unit& u, int wr, int wc, int fr, int fq, const LAS float* rt) const {
        const int row0 = u.pm * BM + wr * 64 + fr; int colt = u.pn * BM; const int t = colt >> 10; colt -= t << 10;
        bf16_t* base = O + (size_t)t * ((size_t)T * DM); const int col0 = colt + wc * 32 + 8 * fq;
        if (t == 2 || t == 3) {
            float rx[8];
#pragma unroll
            for (int ai = 0; ai < 2; ++ai)
#pragma unroll
                for (int m = 0; m < 4; ++m) {
                    const int rl = ai * HALF + wr * 64 + m * 16 + fr; const float r = rt[rl]; rx[ai * 4 + m] = r;
#pragma unroll
                    for (int bj = 0; bj < 2; ++bj) { const f32x4 v0 = acc[ai][bj][m][0] * r, v1 = acc[ai][bj][m][1] * r;
                        float s = (v0[0] * v0[0] + v0[1] * v0[1]) + (v0[2] * v0[2] + v0[3] * v0[3]) + (v1[0] * v1[0] + v1[1] * v1[1]) + (v1[2] * v1[2] + v1[3] * v1[3]);
                        s += __shfl_xor(s, 16); s += __shfl_xor(s, 32);
                        if (fq == 0) P[(rl * 2 + bj) * 4 + wc] = s; }
                }
            asm volatile("s_waitcnt lgkmcnt(0)" ::: "memory"); __builtin_amdgcn_s_barrier(); asm volatile("" ::: "memory");
            const float* gp = (t == 2 ? qn : kn) + wc * 32 + 8 * fq; const f32x4 g0 = *(const f32x4*)gp, g1 = *(const f32x4*)(gp + 4);
            const float qs = (t == 2) ? 0.08838834764831845f * LOG2E : 1.f;
#pragma unroll
            for (int ai = 0; ai < 2; ++ai)
#pragma unroll
                for (int m = 0; m < 4; ++m) {
                    const int rl = ai * HALF + wr * 64 + m * 16 + fr; const float r = rx[ai * 4 + m];
#pragma unroll
                    for (int bj = 0; bj < 2; ++bj) { const f32x4 pp = *(const LAS f32x4*)(P + (rl * 2 + bj) * 4);
                        const float rn = rsqrtf(((pp[0] + pp[1]) + (pp[2] + pp[3])) * (1.f / HD) + EPS) * qs * r;
                        const f32x4 v0 = acc[ai][bj][m][0] * rn * g0, v1 = acc[ai][bj][m][1] * rn * g1;
                        u32x4 w; w.x = cvtpk(v0[0], v0[1]); w.y = cvtpk(v0[2], v0[3]); w.z = cvtpk(v1[0], v1[1]); w.w = cvtpk(v1[2], v1[3]);
                        __builtin_nontemporal_store(w, (u32x4*)(base + (size_t)(u.pm * BM + rl) * DM + col0 + bj * HALF)); }
                }
            return;
        }
#pragma unroll
        for (int ai = 0; ai < 2; ++ai)
#pragma unroll
            for (int m = 0; m < 4; ++m) {
                const int row = row0 + ai * HALF + m * 16; const float r = rt[ai * HALF + wr * 64 + m * 16 + fr];
#pragma unroll
                for (int bj = 0; bj < 2; ++bj) { const f32x4 v0 = acc[ai][bj][m][0] * r, v1 = acc[ai][bj][m][1] * r;
                    u32x4 w; w.x = cvtpk(v0[0], v0[1]); w.y = cvtpk(v0[2], v0[3]); w.z = cvtpk(v1[0], v1[1]); w.w = cvtpk(v1[2], v1[3]);
                    __builtin_nontemporal_store(w, (u32x4*)(base + (size_t)row * DM + col0 + bj * HALF)); }
            }
    }
};
struct EpiPlain {
    static constexpr bool PERM = true;
    __device__ __forceinline__ void init(Acc& acc, const Unit&, int, int, int, int) const { zero_acc(acc); }
    __device__ __forceinline__ void prep(int, int&, int&, LAS float*, int) const {}
    bf16_t* O;
    __device__ __forceinline__ void operator()(const Acc& acc, const Unit& u, int wr, int wc, int fr, int fq, const LAS float* rt) const {
        const int row0 = u.pm * BM + wr * 64 + fr, col0 = u.pn * BM + wc * 32 + 8 * fq;
#pragma unroll
        for (int ai = 0; ai < 2; ++ai)
#pragma unroll
            for (int m = 0; m < 4; ++m) {
                const int row = row0 + ai * HALF + m * 16;
#pragma unroll
                for (int bj = 0; bj < 2; ++bj) { const f32x4 v0 = acc[ai][bj][m][0], v1 = acc[ai][bj][m][1];
                    u32x4 w; w.x = cvtpk(v0[0], v0[1]); w.y = cvtpk(v0[2], v0[3]); w.z = cvtpk(v1[0], v1[1]); w.w = cvtpk(v1[2], v1[3]);
                    __builtin_nontemporal_store(w, (u32x4*)(O + (size_t)row * DM + col0 + bj * HALF)); }
            }
    }
};
struct EpiGate {
    static constexpr bool PERM = true;
    __device__ __forceinline__ void init(Acc& acc, const Unit&, int, int, int, int) const { zero_acc(acc); }
    __device__ __forceinline__ void prep(int, int&, int&, LAS float*, int) const {}
    const bf16_t* rxc; bf16_t* L; bf16_t* U; const float* ba; const float* bx; const float* sp8;
    __device__ __forceinline__ void operator()(const Acc& acc, const Unit& u, int wr, int wc, int fr, int fq, const LAS float* rt) const {
        const int row0 = u.pm * BM + wr * 64 + fr, c0 = u.pn * 128 + wc * 32 + 8 * fq;
        asm volatile("" ::: "memory");
        u32x4 xq0 = *(const u32x4*)(rxc + (size_t)row0 * DM + c0), xq1 = *(const u32x4*)(rxc + (size_t)(row0 + 16) * DM + c0);
#pragma unroll
        for (int ai = 0; ai < 2; ++ai)
#pragma unroll
            for (int m = 0; m < 4; ++m) {
                const int row = row0 + ai * HALF + m * 16; const size_t off = (size_t)row * DM + c0;
                const u32x4 xr = xq0; xq0 = xq1;
                { const int k2 = ai * 4 + m + 2; if (k2 < 8) xq1 = *(const u32x4*)(rxc + (size_t)(row0 + (k2 >> 2) * HALF + (k2 & 3) * 16) * DM + c0); }
                const float xc[8] = {bflo(xr.x), bfhi(xr.x), bflo(xr.y), bfhi(xr.y), bflo(xr.z), bfhi(xr.z), bflo(xr.w), bfhi(xr.w)};
                unsigned wl[4], wu[4];
#pragma unroll
                for (int n = 0; n < 2; ++n) {
                    const f32x4 vba = *(const f32x4*)(ba + c0 + 4 * n), vbx = *(const f32x4*)(bx + c0 + 4 * n), vsp = *(const f32x4*)(sp8 + c0 + 4 * n);
                    float la[4], uu[4];
#pragma unroll
                    for (int e = 0; e < 4; ++e) {
                        const float rg = sigmoidf_(acc[ai][0][m][n][e] + vba[e]), ig = sigmoidf_(acc[ai][1][m][n][e] + vbx[e]);
                        const float l = -vsp[e] * rg, y = 2.f * l;
                        const float om = (y > -0.01f) ? -y * (1.f + y * (0.5f + y * (1.f / 6.f))) : 1.f - __builtin_amdgcn_exp2f(y * LOG2E);
                        la[e] = l; uu[e] = __builtin_amdgcn_sqrtf(om) * ig * xc[n * 4 + e]; }
                    wl[2 * n] = cvtpk(la[0], la[1]); wl[2 * n + 1] = cvtpk(la[2], la[3]); wu[2 * n] = cvtpk(uu[0], uu[1]); wu[2 * n + 1] = cvtpk(uu[2], uu[3]);
                }
                __builtin_nontemporal_store((u32x4){wl[0], wl[1], wl[2], wl[3]}, (u32x4*)(L + off)); __builtin_nontemporal_store((u32x4){wu[0], wu[1], wu[2], wu[3]}, (u32x4*)(U + off));
                asm volatile("" ::: "memory");
            }
    }
};
template <bool ADD> struct EpiMerge {
    static constexpr bool PERM = true;
    __device__ __forceinline__ void init(Acc& acc, const Unit&, int, int, int, int) const { zero_acc(acc); }
    __device__ __forceinline__ void prep(int, int&, int&, LAS float*, int) const {}
    const bf16_t* Gt; const float* mb; const bf16_t* prev; bf16_t* O;
    __device__ __forceinline__ void operator()(const Acc& acc, const Unit& u, int wr, int wc, int fr, int fq, const LAS float* rt) const {
        const int row0 = u.pm * BM + wr * 64 + fr, col0 = u.pn * BM + wc * 32 + 8 * fq;
#pragma unroll
        for (int bj = 0; bj < 2; ++bj) {
            const int c = col0 + bj * HALF; float vmb[8];
#pragma unroll
            for (int j = 0; j < 8; ++j) vmb[j] = mb[c + j];
#pragma unroll
            for (int ai = 0; ai < 2; ++ai) {
            asm volatile("" ::: "memory");
            u32x4 gr[4], pr[4];
#pragma unroll
            for (int k = 0; k < 4; ++k) { const size_t off = (size_t)(row0 + ai * HALF + k * 16) * DM + c;
                gr[k] = *(const u32x4*)(Gt + off); if (ADD) pr[k] = *(const u32x4*)(prev + off); }
#pragma unroll
            for (int k = 0; k < 4; ++k) {
                const int m = k; const size_t off = (size_t)(row0 + ai * HALF + m * 16) * DM + c;
                const float gv[8] = {bflo(gr[k].x), bfhi(gr[k].x), bflo(gr[k].y), bfhi(gr[k].y), bflo(gr[k].z), bfhi(gr[k].z), bflo(gr[k].w), bfhi(gr[k].w)};
                float pv[8] = {0.f, 0.f, 0.f, 0.f, 0.f, 0.f, 0.f, 0.f};
                if (ADD) { pv[0] = bflo(pr[k].x); pv[1] = bfhi(pr[k].x); pv[2] = bflo(pr[k].y); pv[3] = bfhi(pr[k].y); pv[4] = bflo(pr[k].z); pv[5] = bfhi(pr[k].z); pv[6] = bflo(pr[k].w); pv[7] = bfhi(pr[k].w); }
                float o[8];
#pragma unroll
                for (int n = 0; n < 2; ++n)
#pragma unroll
                    for (int e = 0; e < 4; ++e) { const int j = n * 4 + e; o[j] = pv[j] + sigmoidf_(gv[j] + vmb[j]) * acc[ai][bj][m][n][e]; }
                u32x4 w; w.x = cvtpk(o[0], o[1]); w.y = cvtpk(o[2], o[3]); w.z = cvtpk(o[4], o[5]); w.w = cvtpk(o[6], o[7]);
                *(u32x4*)(O + off) = w;
            }
            }
        }
    }
};
}

namespace att {
using bf16 = __hip_bfloat16;
constexpr int NW = 8, QBLK = 32, KVBLK = 64, QB = NW * QBLK, D = 128, LD = 1024;
constexpr int SHM_V = KVBLK * D * 2, SHM_K = KVBLK * D * 2;
constexpr int OFF_WS = 2 * SHM_V + 2 * SHM_K, OFF_KB = OFF_WS + NW * 64 * 4, ATT_LDS = OFF_KB + 2 * 64 * 4;
constexpr float THR = 8.f;
#define KSWZ(row, colB) ((row) * 256 + ((colB) ^ (((row) & 7) << 4)))
#define SBAR() __builtin_amdgcn_sched_barrier(0)
__device__ __forceinline__ int v_st(int k, int c) { const int kk = (k & ~0xC) | ((k & 4) << 1) | ((k & 8) >> 1); return ((kk >> 3) * 4 + (c >> 5)) * 512 + ((kk & 7) * 32 + (c & 31)) * 2; }
__device__ __forceinline__ int v_rd_base(int lane) { return ((lane & 3) << 3) | (((lane >> 2) & 3) << 6) | (((lane >> 4) & 1) << 5) | (((lane >> 5) & 1) << 8); }
constexpr int v_rd_off(int d0, int ks, int half) { return d0 * 512 + ks * 4096 + half * 2048; }
__device__ __forceinline__ int crow(int r, int hi) { return (r & 3) + 8 * (r >> 2) + 4 * hi; }
__device__ __forceinline__ bf16x8 load8(const bf16* p) { return *reinterpret_cast<const bf16x8*>(p); }
__device__ __forceinline__ void mask_tile(f32x16& p0, f32x16& p1, int dq) {
    const float NEG = -__builtin_inff();
#pragma unroll
    for (int r = 0; r < 16; ++r) {
        const int c = (r & 3) + 8 * (r >> 2);
        if (dq - c < 0) p0[r] = NEG;
        if (dq - c - 32 < 0) p1[r] = NEG;
    }
}
__device__ __forceinline__ void partialSM(f32x16& p0, f32x16& p1, float& m_reg, float& mn, float& alpha) {
    float pmax = p0[0];
#pragma unroll
    for (int r = 1; r < 16; ++r) pmax = fmaxf(pmax, p0[r]);
#pragma unroll
    for (int r = 0; r < 16; ++r) pmax = fmaxf(pmax, p1[r]);
    { auto rr = __builtin_amdgcn_permlane32_swap(__float_as_uint(pmax), __float_as_uint(pmax), false, false);
      pmax = fmaxf(__uint_as_float(rr[0]), __uint_as_float(rr[1])); }
    if (__builtin_expect(__all((pmax - m_reg) <= THR), 1)) { mn = m_reg; alpha = 1.f; }
    else { mn = fmaxf(m_reg, pmax); alpha = __builtin_amdgcn_exp2f(m_reg - mn); m_reg = mn; }
#pragma unroll
    for (int r = 0; r < 16; ++r) p0[r] = p0[r] - mn;
#pragma unroll
    for (int r = 0; r < 16; ++r) p1[r] = p1[r] - mn;
#pragma unroll
    for (int r = 0; r < 16; ++r) p0[r] = __builtin_amdgcn_exp2f(p0[r]);
}
__device__ __forceinline__ void finishSM(f32x16& p0, f32x16& p1, float alpha, float& l_reg, bf16x8& pa0, bf16x8& pa1, bf16x8& pa2, bf16x8& pa3) {
#pragma unroll
    for (int r = 0; r < 16; ++r) p1[r] = __builtin_amdgcn_exp2f(p1[r]);
    float ps = 0;
#pragma unroll
    for (int r = 0; r < 16; ++r) ps += p0[r];
#pragma unroll
    for (int r = 0; r < 16; ++r) ps += p1[r];
    { auto rr = __builtin_amdgcn_permlane32_swap(__float_as_uint(ps), __float_as_uint(ps), false, false);
      ps = __uint_as_float(rr[0]) + __uint_as_float(rr[1]); }
    l_reg = l_reg * alpha + ps;
#define PK4(P, B_, OUT) do { unsigned a0 = cvtpk(P[B_+0], P[B_+1]), a1 = cvtpk(P[B_+2], P[B_+3]);                          \
        unsigned b0 = cvtpk(P[B_+4], P[B_+5]), b1 = cvtpk(P[B_+6], P[B_+7]);                                             \
        auto r0 = __builtin_amdgcn_permlane32_swap(a0, b0, false, false); auto r1 = __builtin_amdgcn_permlane32_swap(a1, b1, false, false); \
        u32x4 w = {r0[0], r1[0], r0[1], r1[1]}; OUT = *reinterpret_cast<bf16x8*>(&w); } while (0)
    PK4(p0, 0, pa0); PK4(p0, 8, pa1); PK4(p1, 0, pa2); PK4(p1, 8, pa3);
#undef PK4
}
template <int KB>
__device__ __forceinline__ void qkt(f32x16& p0, f32x16& p1, const char* K_lds, const float* kbias, int r32, int hi, const bf16x8* qr) {
    { const float* kb_ = kbias + KB * 64 + 4 * hi;
#pragma unroll
      for (int g = 0; g < 4; ++g) { const f32x4 b0 = *(const f32x4*)(kb_ + 8 * g), b1 = *(const f32x4*)(kb_ + 32 + 8 * g);
#pragma unroll
          for (int j = 0; j < 4; ++j) { p0[4 * g + j] = b0[j]; p1[4 * g + j] = b1[j]; } } }
    const char* kb[4];
#pragma unroll
    for (int dd = 0; dd < 4; ++dd) kb[dd] = K_lds + KB * SHM_K + KSWZ(r32, (dd * 16 + hi * 8) * 2);
#pragma unroll
    for (int d0 = 0; d0 < 8; ++d0) { const char* a = kb[d0 & 3] + (d0 >> 2) * 128;
        bf16x8 b0 = *reinterpret_cast<const bf16x8*>(a);
        bf16x8 b1 = *reinterpret_cast<const bf16x8*>(a + 32 * 256);
        p0 = __builtin_amdgcn_mfma_f32_32x32x16_bf16(b0, qr[d0], p0, 0, 0, 0);
        p1 = __builtin_amdgcn_mfma_f32_32x32x16_bf16(b1, qr[d0], p1, 0, 0, 0); }
}
template <int VB>
__device__ __forceinline__ void pv_tile(f32x16* o, int vb0, bf16x8 pa0, bf16x8 pa1, bf16x8 pa2, bf16x8 pa3) {
#define TRRD(dst, off) asm volatile("ds_read_b64_tr_b16 %0, %1 offset:%2" : "=&v"(dst) : "v"(vb0), "i"(off) : "memory")
#define PV_D0(d0) do { s16x4 l0, l1, l2, l3, h0, h1, h2, h3; constexpr int b_ = VB * SHM_V + v_rd_off(d0, 0, 0); \
        TRRD(l0, b_); TRRD(h0, b_ + 2048); TRRD(l1, b_ + 4096); TRRD(h1, b_ + 6144); TRRD(l2, b_ + 8192); TRRD(h2, b_ + 10240); TRRD(l3, b_ + 12288); TRRD(h3, b_ + 14336); \
        asm volatile("s_waitcnt lgkmcnt(0)" ::: "memory"); SBAR(); \
        o[d0] = __builtin_amdgcn_mfma_f32_32x32x16_bf16(pa0, (bf16x8){l0[0], l0[1], l0[2], l0[3], h0[0], h0[1], h0[2], h0[3]}, o[d0], 0, 0, 0);   \
        o[d0] = __builtin_amdgcn_mfma_f32_32x32x16_bf16(pa1, (bf16x8){l1[0], l1[1], l1[2], l1[3], h1[0], h1[1], h1[2], h1[3]}, o[d0], 0, 0, 0);   \
        o[d0] = __builtin_amdgcn_mfma_f32_32x32x16_bf16(pa2, (bf16x8){l2[0], l2[1], l2[2], l2[3], h2[0], h2[1], h2[2], h2[3]}, o[d0], 0, 0, 0);   \
        o[d0] = __builtin_amdgcn_mfma_f32_32x32x16_bf16(pa3, (bf16x8){l3[0], l3[1], l3[2], l3[3], h3[0], h3[1], h3[2], h3[3]}, o[d0], 0, 0, 0); } while (0)
    PV_D0(0); PV_D0(1); PV_D0(2); PV_D0(3);
#undef PV_D0
#undef TRRD
}
struct BlockRef { const bf16* Q; const bf16* K; const bf16* V; bf16* O; const float* ND; int P0; int jlo; };
struct Seam { bf16x8 qr[8]; bf16x8 st_v0, st_v1, st_k0, st_k1; };
#define ROW(p, k0, rr) ((p) + (size_t)((k0) + (rr)) * LD + sc)
#define VMW() asm volatile("s_waitcnt vmcnt(0)" ::: "memory")
#define VMWN(n) asm volatile("s_waitcnt vmcnt(%0)" :: "i"(n) : "memory")
#define SLOAD_H(Kp, Vp, NDp, k0, bf) do { S.st_v0 = load8(ROW(Vp, k0, sr)); S.st_v1 = load8(ROW(Vp, k0, 32 + sr));              \
                         S.st_k0 = load8(ROW(Kp, k0, sr)); S.st_k1 = load8(ROW(Kp, k0, 32 + sr));                              \
                         if (wid == 0) __builtin_amdgcn_global_load_lds((const unsigned*)((NDp) + (k0) + lane), (LAS unsigned*)(kbias3 + (bf) * 64), 4, 0, 0); } while (0)
#define SWRITE_HK(bf) do { *(bf16x8*)(K_lds + (bf) * SHM_K + kws) = S.st_k0; *(bf16x8*)(K_lds + (bf) * SHM_K + kws + 32 * 256) = S.st_k1; } while (0)
#define SWRITE_HV(bf) do { *(bf16x8*)(V_lds + (bf) * SHM_V + vst0) = S.st_v0; *(bf16x8*)(V_lds + (bf) * SHM_V + vst1) = S.st_v1; } while (0)
#define SWRITE_H(bf) do { SWRITE_HV(bf); SWRITE_HK(bf); } while (0)
__device__ __forceinline__ void attn_prime(const BlockRef& cur, char* lds, Seam& S) {
    int tid = threadIdx.x; asm volatile("" : "+v"(tid)); const int wid = __builtin_amdgcn_readfirstlane(tid >> 6), lane = tid & 63, r32 = lane & 31, hi = lane >> 5;
    const int sr = tid >> 4, sc = (tid & 15) * 8, kws = KSWZ(sr, sc * 2); char* K_lds = lds + 2 * SHM_V; LAS float* kbias3 = (LAS float*)(LAS char*)lds + OFF_KB / 4;
#pragma unroll
    for (int d0 = 0; d0 < 8; ++d0) S.qr[d0] = load8(cur.Q + (size_t)(wid * QBLK + r32) * LD + d0 * 16 + hi * 8);
    SLOAD_H(cur.K, cur.V, cur.ND, cur.P0 + QB - KVBLK, 0); VMW(); SWRITE_HK(0);
    __syncthreads();
}
__device__ __forceinline__ void attn_block(const BlockRef& cur, const BlockRef& nxt, char* lds, Seam& S) {
    int tid = threadIdx.x; asm volatile("" : "+v"(tid)); const int wid = __builtin_amdgcn_readfirstlane(tid >> 6), lane = tid & 63, r32 = lane & 31, hi = lane >> 5;
    const int j_lo = cur.jlo, NT = (cur.P0 + QB) / KVBLK - j_lo;
    const int qlo = cur.P0 + wid * QBLK, qm = qlo + r32 - 4 * hi;
    char* V_lds = lds; char* K_lds = lds + 2 * SHM_V; const float* kbias = (const float*)(lds + OFF_KB); LAS float* kbias3 = (LAS float*)(LAS char*)lds + OFF_KB / 4;
    float* ws = (float*)(lds + OFF_WS) + wid * 64; float* li_l = ws, * al_l = ws + 32;
    float m_reg = -1e30f, l_reg = 0; f32x16 o[4] = {};
    const int sr = tid >> 4, sc = (tid & 15) * 8, vst0 = v_st(sr, sc), vst1 = v_st(32 + sr, sc), kws = KSWZ(sr, sc * 2);
    const int vb0 = (int)(uintptr_t)V_lds + v_rd_base(lane);
    const bf16* Kh = cur.K; const bf16* Vh = cur.V; const float* NDh = cur.ND;
#define RESC(a) do { if (__any((a) < 1.f)) { if (hi == 0) al_l[r32] = (a); asm volatile("s_waitcnt lgkmcnt(0)" ::: "memory");              \
                     for (int d_ = 0; d_ < 4; ++d_) for (int r = 0; r < 16; ++r) o[d_][r] *= al_l[crow(r, hi)]; } } while (0)
#define KBASE(t) ((j_lo + NT - 1 - (t)) * KVBLK)
#define MASKT(P0_, P1_, t) do { const int kb_ = KBASE(t); if (kb_ + KVBLK - 1 > qlo) mask_tile(P0_, P1_, qm - kb_); } while (0)
#define SEAM_K0() do { VMWN(8); SWRITE_HK(0); SBAR(); } while (0)
    f32x16 pA0, pA1, pB0, pB1; float mnA, mnB, alA, alB; bf16x8 pa0, pa1, pa2, pa3;
    SWRITE_HV(0); SBAR();
    SLOAD_H(Kh, Vh, NDh, KBASE(1), 1);
    SBAR(); qkt<0>(pA0, pA1, K_lds, kbias, r32, hi, S.qr);
    MASKT(pA0, pA1, 0); partialSM(pA0, pA1, m_reg, mnA, alA);
    VMW(); SWRITE_H(1);
    __syncthreads();
#define HALF_STEP(PX0, PX1, mnX, alX, PY0, PY1, alY, t, KB, VB, SB) do {                                                      \
        SBAR(); qkt<KB>(PX0, PX1, K_lds, kbias, r32, hi, S.qr);                                                               \
        finishSM(PY0, PY1, alY, l_reg, pa0, pa1, pa2, pa3); SBAR();                                                           \
        if ((t) + 1 < NT) { SLOAD_H(Kh, Vh, NDh, KBASE((t) + 1), SB); SBAR(); }                                               \
        pv_tile<VB>(o, vb0, pa0, pa1, pa2, pa3); MASKT(PX0, PX1, (t)); partialSM(PX0, PX1, m_reg, mnX, alX);                  \
        __syncthreads();                                                                                                      \
        if ((t) + 1 < NT) { VMW(); SWRITE_H(SB); }                                                                            \
        RESC(alX); __syncthreads(); } while (0)
    for (int t = 1; t + 1 < NT; t += 2) {
        HALF_STEP(pB0, pB1, mnB, alB, pA0, pA1, alA, t, 1, 0, 0);
        HALF_STEP(pA0, pA1, mnA, alA, pB0, pB1, alB, t + 1, 0, 1, 1);
    }
    SBAR(); qkt<1>(pB0, pB1, K_lds, kbias, r32, hi, S.qr); SBAR();
    SLOAD_H(nxt.K, nxt.V, nxt.ND, nxt.P0 + QB - KVBLK, 0); SBAR();
#pragma unroll
    for (int d0 = 0; d0 < 8; ++d0) S.qr[d0] = load8(nxt.Q + (size_t)(wid * QBLK + r32) * LD + d0 * 16 + hi * 8);
    SBAR();
    finishSM(pA0, pA1, alA, l_reg, pa0, pa1, pa2, pa3); SBAR();
    pv_tile<0>(o, vb0, pa0, pa1, pa2, pa3);
    MASKT(pB0, pB1, NT - 1); partialSM(pB0, pB1, m_reg, mnB, alB); __syncthreads(); RESC(alB);
    finishSM(pB0, pB1, alB, l_reg, pa0, pa1, pa2, pa3); SBAR(); pv_tile<1>(o, vb0, pa0, pa1, pa2, pa3);
    SBAR(); SEAM_K0();
    if (hi == 0) li_l[r32] = l_reg; asm volatile("s_waitcnt lgkmcnt(0)" ::: "memory");
    float rli[16];
#pragma unroll
    for (int r = 0; r < 16; ++r) rli[r] = __builtin_amdgcn_rcpf(li_l[crow(r, hi)]);
    bf16* Ow = cur.O + (size_t)(wid * QBLK) * LD;
#pragma unroll
    for (int r = 0; r < 16; ++r) { const int orow = crow(r, hi);
#pragma unroll
        for (int d0 = 0; d0 < 4; ++d0) { const float v = o[d0][r] * rli[r];
            const float vn = __shfl_xor(v, 1);
            if ((r32 & 1) == 0) *(unsigned*)(Ow + (size_t)orow * LD + d0 * 32 + r32) = cvtpk(v, vn); } }
    __syncthreads();
#undef RESC
#undef KBASE
#undef MASKT
#undef SEAM_K0
#undef HALF_STEP
}
#undef ROW
#undef VMW
#undef VMWN
#undef SLOAD_H
#undef SWRITE_HK
#undef SWRITE_HV
#undef SWRITE_H
__device__ __forceinline__ float ld_agent(const float* p) { const float v = __hip_atomic_load(p, __ATOMIC_RELAXED, __HIP_MEMORY_SCOPE_AGENT); return __uint_as_float(__builtin_amdgcn_readfirstlane(__float_as_uint(v))); }
__device__ __forceinline__ BlockRef mk_ref(int i, float C, const bf16* Q, const bf16* K, const bf16* V, bf16* O, const float* ND) {
    const int bh = i & 31, qb = 31 - (i >> 5), b = bh >> 3, h = bh & 7;
    const size_t hoff = (size_t)b * SEQ * LD + (size_t)h * D;
    BlockRef r; r.P0 = qb * QB;
    r.Q = Q + hoff + (size_t)r.P0 * LD; r.O = O + hoff + (size_t)r.P0 * LD; r.K = K + hoff; r.V = V + hoff; r.ND = ND + (size_t)bh * SEQ;
    const float thr = ld_agent(r.ND + r.P0) - C;
    int lo = 0, hi = r.P0 / KVBLK;
    while (lo < hi) { const int mid = (lo + hi) >> 1; if (ld_agent(r.ND + mid * KVBLK + KVBLK - 1) >= thr) hi = mid; else lo = mid + 1; }
    r.jlo = __builtin_amdgcn_readfirstlane(lo & ~1);
    return r;
}
__device__ __forceinline__ void attn_phase(char* lds, const bf16* Q, const bf16* K, const bf16* V, bf16* O, const float* ND, unsigned* ctr, const float* qn, const float* kn) {
    constexpr int total = NB * NH * 32;
    volatile int* slot = (volatile int*)(lds + ATT_LDS);
    int tid = threadIdx.x; asm volatile("" : "+v"(tid));
    float C;
    { float gq = 0.f, gk = 0.f;
      for (int j = 0; j < D; ++j) { gq = fmaxf(gq, fabsf(qn[j])); gk = fmaxf(gk, fabsf(kn[j])); }
      C = 2.f * 16.65f * gq * gk + 24.f + ((PROBE == 7) ? 75.f : 0.f); C = __uint_as_float(__builtin_amdgcn_readfirstlane(__float_as_uint(C))); }
    if (tid == 0) slot[0] = (int)atomicAdd(ctr, 1u);
    __syncthreads();
    int L = slot[0]; L = __builtin_amdgcn_readfirstlane(L);
    if (L >= total) return;
    BlockRef cur = mk_ref(L, C, Q, K, V, O, ND);
    if (tid == 0) slot[1] = (int)atomicAdd(ctr, 1u);
    Seam S;
    attn_prime(cur, lds, S);
    for (int it = 1;; ++it) {
        int Ln = slot[it & 1]; Ln = __builtin_amdgcn_readfirstlane(Ln);
        const bool last = Ln >= total;
        const BlockRef nxt = last ? cur : mk_ref(Ln, C, Q, K, V, O, ND);
        if (!last && tid == 0) slot[(it + 1) & 1] = (int)atomicAdd(ctr, 1u);
        attn_block(cur, nxt, lds, S);
        if (last) break;
        cur = nxt;
    }
}
#undef KSWZ
#undef SBAR
}


#define XB_TMO      128
#define XB_XCNT(j)  (256  + 64 * (j))
#define XB_XSUB(j)  (1280 + 64 * (j))
#define XB_XGEN(j)  (2304 + 64 * (j))
#define XB_TOP      3328
#define XB_TOPGEN   3392
#define XCD_BAR_WORDS 3456
#define XB_SPIN_CAP (1u << 22)
constexpr size_t WS_BAR = WS_VEC + 524288;
constexpr int LDS_BARST = LDS_BYTES - 64;
__device__ __forceinline__ unsigned xb_ld(unsigned* p)              { return __hip_atomic_load(p, __ATOMIC_RELAXED, __HIP_MEMORY_SCOPE_AGENT); }
__device__ __forceinline__ unsigned xb_add(unsigned* p, unsigned v) { return __hip_atomic_fetch_add(p, v, __ATOMIC_RELAXED, __HIP_MEMORY_SCOPE_AGENT); }
__device__ __forceinline__ unsigned xb_xcc_id() { return (unsigned)__builtin_amdgcn_s_getreg((3 << 11) | 20) & 0xFu; }
#define XB_SPIN(cond, bar) do { unsigned _sp = 0; while (cond) { __builtin_amdgcn_s_sleep(1); \
    if ((++_sp & 255u) == 0u) { if (xb_ld(&(bar)[XB_TMO])) break; if (_sp > XB_SPIN_CAP) { atomicAdd(&(bar)[XB_TMO], 1u); break; } } } } while (0)
__device__ __forceinline__ void xcd_barrier_complete(unsigned* bar, unsigned x, unsigned& nloc, unsigned& nx) {
    const unsigned G = gridDim.x * gridDim.y * gridDim.z;
    unsigned sum, cnt, mine, sp = 0u;
    for (;;) {
        sum = 0u; cnt = 0u; mine = 0u;
#pragma unroll
        for (unsigned j = 0; j < 16; ++j) { const unsigned c = xb_ld(&bar[XB_XCNT(j)]); sum += c; cnt += (c > 0u) ? 1u : 0u; mine = (j == x) ? c : mine; }
        if (sum == G) break;
        __builtin_amdgcn_s_sleep(1);
        if ((++sp & 255u) == 0u) { if (xb_ld(&bar[XB_TMO])) break; if (sp > XB_SPIN_CAP) { atomicAdd(&bar[XB_TMO], 1u); break; } }
    }
    nloc = mine > 0u ? mine : 1u; nx = cnt > 0u ? cnt : 1u;
}
__device__ __forceinline__ void xcd_barrier(unsigned* bar, volatile LAS unsigned* st) {
    asm volatile("s_waitcnt vmcnt(0)" ::: "memory");
    __syncthreads();
    if (threadIdx.x == 0) {
        const unsigned x = xb_xcc_id();
        __builtin_amdgcn_s_waitcnt(0);
        unsigned nloc = st[0], nx = st[1];
        if (nloc == 0u) { xcd_barrier_complete(bar, x, nloc, nx); st[0] = nloc; st[1] = nx; }
        const unsigned old = xb_add(&bar[XB_XSUB(x)], 1u);
        const unsigned gen = old / nloc;
        if (old + 1u == (gen + 1u) * nloc) {
            __builtin_amdgcn_fence(__ATOMIC_RELEASE, "agent");
            asm volatile("s_waitcnt vmcnt(0)" ::: "memory");
            const unsigned og = xb_add(&bar[XB_TOP], 1u);
            const unsigned tg = og / nx;
            if (og + 1u == (tg + 1u) * nx) xb_add(&bar[XB_TOPGEN], 1u);
            else XB_SPIN(xb_ld(&bar[XB_TOPGEN]) == tg, bar);
            __builtin_amdgcn_fence(__ATOMIC_ACQUIRE, "agent");
            xb_add(&bar[XB_XGEN(x)], 1u);
            asm volatile("s_waitcnt vmcnt(0)" ::: "memory");
        } else {
            XB_SPIN(xb_ld(&bar[XB_XGEN(x)]) == gen, bar);
            __builtin_amdgcn_fence(__ATOMIC_ACQUIRE, "agent");
            asm volatile("s_waitcnt vmcnt(0)" ::: "memory");
        }
    }
    __syncthreads();
}
#ifndef PHMASK
#define PHMASK 0xffff
#endif
#ifndef PROBE
#define PROBE 0
#endif
__device__ __forceinline__ int opaque_i(int v) { asm volatile("" : "+s"(v)); return v; }
#define REP(n) for (int rep_ = 0, nrep_ = ((PROBE == (n)) ? opaque_i(2) : 1); rep_ < nrep_; ++rep_)
#define PH(n) ((PHMASK >> (n)) & 1)
struct Params { const float* in[29]; float* out; unsigned char* ws; };
enum { I_X = 0, I_P, I_F1N, I_F1IN, I_F1OUT, I_MIXN, I_WIN, I_MERGEB, I_CONVW, I_CONVB, I_RGWA, I_RGBA, I_RGWX, I_RGBX, I_RGLAM, I_FB, I_QN, I_KN,
       I_WRNN, I_WATT, I_WO, I_F2N, I_F2IN, I_F2OUT, I_PLEN, I_PLEWG, I_PLEBG, I_PLEWP, I_FINALN };

__device__ __forceinline__ float wave_sum(float v) {
#pragma unroll
    for (int o = 1; o < 64; o <<= 1) v += __shfl_xor(v, o);
    return v;
}
__device__ __forceinline__ void tr_item(const float* W, int ldw, int scol, const float* gain, float wscale, bf16_t* WT, int K, int drow, int k0, LAS float* scr, int lane) {
#pragma unroll
    for (int i = 0; i < 32; ++i) { const int kk = 2 * i + (lane >> 5); float v = W[(size_t)(k0 + kk) * ldw + scol + (lane & 31)]; if (gain) v *= gain[k0 + kk]; scr[kk * 33 + (lane & 31)] = v * wscale; }
    LDS_WAIT(); asm volatile("" ::: "memory");
    const int c = lane & 7;
#pragma unroll
    for (int j = 0; j < 4; ++j) { const int n = (lane >> 3) + 8 * j; const LAS float* s = scr + (8 * c) * 33 + n;
        u32x4 o; o.x = cvtpk(s[0 * 33], s[1 * 33]); o.y = cvtpk(s[2 * 33], s[3 * 33]); o.z = cvtpk(s[4 * 33], s[5 * 33]); o.w = cvtpk(s[6 * 33], s[7 * 33]);
        *(u32x4*)(WT + (size_t)(drow + n) * K + k0 + 8 * c) = o; }
    LDS_WAIT(); asm volatile("" ::: "memory");
}
__device__ __forceinline__ bool tr_seg(int& it, const float* W, int ldw, const float* gain, float wscale, bf16_t* WT, int K, int nrows, int mode, LAS float* scr, int lane) {
    const int nblk = nrows / 32, nit = (K / 64) * nblk;
    if (it >= nit) { it -= nit; return false; }
    const int kb = it / nblk, d0 = (it % nblk) * 32; int scol = d0;
    if (mode == 1) { const int t = d0 >> 8, r = d0 & 255; scol = (r >> 7) * FF + t * 128 + (r & 127); }
    else if (mode == 2) { scol = d0 < 5120 ? d0 : d0 + 8; }
    tr_item(W, ldw, scol, gain, wscale, WT, K, d0, kb * 64, scr, lane);
    return true;
}

#define GRID_SYNC() REP(3) do { xcd_barrier((unsigned*)(P.ws + WS_BAR), (volatile LAS unsigned*)(lds + LDS_BARST)); } while (0)
#define PHASE_IDS_ int tid = threadIdx.x; asm volatile("" : "+v"(tid)); const int lane = tid & 63, wave = __builtin_amdgcn_readfirstlane(tid >> 6), gw = vcu * 8 + wave, gt = bx * 512 + tid; (void)lane; (void)gw; (void)gt;
#define ssA ((float*)(ws + WS_SS0))
#define ssB ((float*)(ws + WS_SS1))
#define logf_ ((float*)(ws + WS_LOGF))
#define nd2 ((float*)(ws + WS_ND2))
#define agg ((float*)(ws + WS_AGG))
#define sp8 ((float*)(ws + WS_VEC))
#define wfg ((float*)(ws + WS_VEC) + 4096)
#define W1in_t ((bf16_t*)(ws + WS_W1IN))
#define W1out_t ((bf16_t*)(ws + WS_W1OUT))
#define Win_t ((bf16_t*)(ws + WS_WIN))
#define Wg_t ((bf16_t*)(ws + WS_WG))
#define Wr_t ((bf16_t*)(ws + WS_WR))
#define Wat_t ((bf16_t*)(ws + WS_WAT))
#define Wo_t ((bf16_t*)(ws + WS_WO))
#define W2in_t ((bf16_t*)(ws + WS_W2IN))
#define W2out_t ((bf16_t*)(ws + WS_W2OUT))
#define Wpg_t ((bf16_t*)(ws + WS_WPG))
#define Wpe_t ((bf16_t*)(ws + WS_WPE))
#define xb ((bf16_t*)(ws + WS_XB))
#define pb ((bf16_t*)(ws + WS_PB))
#define R ((bf16_t*)(ws + WS_R))
#define X1 ((bf16_t*)(ws + WS_X1))
#define act R
#define b_rx R
#define b_rgate (R + (size_t)T * DM)
#define b_q (R + 2 * (size_t)T * DM)
#define b_k (R + 3 * (size_t)T * DM)
#define b_v (R + 4 * (size_t)T * DM)
#define b_ga (R + 5 * (size_t)T * DM)
#define b_gb (R + 6 * (size_t)T * DM)
#define xb2 b_k
#define b_rxc xb
#define b_L b_rx
#define b_U X1
#define b_ya xb
#define b_mrg X1
#define b_E X1
#define xres (P.out + zz)
#define IN(i) (P.in[(i) + zz])
#define PHASE_PTRS int zz; asm volatile("s_mov_b32 %0, 0" : "=s"(zz)); unsigned char* ws = P.ws + zz; int G = G0, bx = bx0, vcu = vcu0; asm volatile("" : "+s"(G), "+s"(bx), "+s"(vcu)); const int NGW = G * 8, NGT = G * 512; (void)NGW; (void)NGT; (void)ws;


template <int LL, int MODE> __device__ __forceinline__ void layer_prep(const Params& P, LAS unsigned char* lds, const int G0, const int bx0, const int vcu0) {
    {
            PHASE_PTRS PHASE_IDS_
            LAS float* scr = (LAS float*)(lds + wave * 16384);
            const float* f1n = IN(I_F1N) + LL * DM; const float* mixn = IN(I_MIXN) + LL * DM; const float* f2n = IN(I_F2N) + LL * DM; const float* plen = IN(I_PLEN) + LL * DM;
            const float* f1in = IN(I_F1IN) + (size_t)LL * DM * 2 * FF; const float* f1out = IN(I_F1OUT) + (size_t)LL * FF * DM;
            const float* win = IN(I_WIN) + (size_t)LL * DM * NIN;
            const float* wrnn = IN(I_WRNN) + (size_t)LL * DM * DM; const float* watt = IN(I_WATT) + (size_t)LL * DM * DM; const float* wo = IN(I_WO) + (size_t)LL * DM * DM;
            const float* f2in = IN(I_F2IN) + (size_t)LL * DM * 2 * FF; const float* f2out = IN(I_F2OUT) + (size_t)LL * FF * DM;
            const float* plewg = IN(I_PLEWG) + (size_t)LL * DM * DM; const float* plewp = IN(I_PLEWP) + (size_t)LL * PLE * DM;
            constexpr int NIT = (MODE == 2) ? 16 * 32 : 16 * 176 + 44 * 32 + 16 * 224 + 3 * 16 * 32 + 16 * 176 + 44 * 32 + 16 * 32 + 4 * 32;
            constexpr int ON = (MODE != 2) ? 1 : 0, ONG = (MODE != 1) ? 1 : 0;
            for (int it0 = gw; it0 < NIT; it0 += NGW) {
                int it = it0;
                if (tr_seg(it, f1in, 2 * FF, f1n, 1.f, W1in_t, DM, ON * 2 * FF, 1, scr, lane)) continue;
                if (tr_seg(it, f1out, DM, nullptr, 0.5f, W1out_t, FF, ON * DM, 0, scr, lane)) continue;
                if (tr_seg(it, win, NIN, mixn, 1.f, Win_t, DM, ON * 7 * DM, 2, scr, lane)) continue;
                if (tr_seg(it, wrnn, DM, nullptr, 1.f, Wr_t, DM, ON * DM, 0, scr, lane)) continue;
                if (tr_seg(it, watt, DM, nullptr, 1.f, Wat_t, DM, ON * DM, 0, scr, lane)) continue;
                if (tr_seg(it, wo, DM, nullptr, 1.f, Wo_t, DM, ON * DM, 0, scr, lane)) continue;
                if (tr_seg(it, f2in, 2 * FF, f2n, 1.f, W2in_t, DM, ON * 2 * FF, 1, scr, lane)) continue;
                if (tr_seg(it, f2out, DM, nullptr, 0.5f, W2out_t, FF, ON * DM, 0, scr, lane)) continue;
                if (tr_seg(it, plewg, DM, plen, 1.f, Wpg_t, DM, ONG * DM, 0, scr, lane)) continue;
                tr_seg(it, plewp, DM, nullptr, 1.f, Wpe_t, PLE, ON * DM, 0, scr, lane);
            }
            if (MODE != 2) {
            const float* rgwa = IN(I_RGWA) + (size_t)LL * 16 * 64 * 64; const float* rgwx = IN(I_RGWX) + (size_t)LL * 16 * 64 * 64;
            for (int e = gt; e < 2048 * 128; e += NGT) {
                const int Rr = e >> 7, kk = e & 127, pn = Rr >> 8, j = Rr & 255, c = 128 * pn + (j & 127), ic = 128 * pn + kk, blk = c >> 6;
                float v = 0.f; if ((ic >> 6) == blk) v = ((j >> 7) ? rgwx : rgwa)[((size_t)blk * 64 + (ic & 63)) * 64 + (c & 63)];
                Wg_t[e] = (bf16_t)(cvtpk(v, 0.f) & 0xffffu);
            }
            const float* lam = IN(I_RGLAM) + LL * DM;
            for (int e = gt; e < DM; e += NGT) sp8[e] = 8.f * log1pf(expf(-lam[e]));
            for (int e = gt; e < DM * 8; e += NGT) { const int k = e >> 3, h = e & 7; wfg[e] = mixn[k] * win[(size_t)k * NIN + 5120 + h]; }
            const float* pl = IN(I_P) + (size_t)LL * T * PLE;
            for (int e0 = gt; e0 < T * PLE / 8; e0 += 4 * NGT) { f32x4 pa[4], pq[4];
#pragma unroll
                for (int k = 0; k < 4; ++k) { const int e = e0 + k * NGT; if (e < T * PLE / 8) { pa[k] = *(const f32x4*)(pl + (size_t)e * 8); pq[k] = *(const f32x4*)(pl + (size_t)e * 8 + 4); } }
#pragma unroll
                for (int k = 0; k < 4; ++k) { const int e = e0 + k * NGT; if (e < T * PLE / 8) { u32x4 w; w.x = cvtpk(pa[k][0], pa[k][1]); w.y = cvtpk(pa[k][2], pa[k][3]); w.z = cvtpk(pq[k][0], pq[k][1]); w.w = cvtpk(pq[k][2], pq[k][3]); *(u32x4*)(pb + (size_t)e * 8) = w; } } }
            if (LL == 0) {
                const float* x0 = IN(I_X);
                for (int row = gw; row < T; row += NGW) {
                    const f32x4* xr = (const f32x4*)(x0 + (size_t)row * DM) + lane; float s = 0.f;
                    u32x2* o8 = (u32x2*)(xb2 + (size_t)row * DM) + lane;
#pragma unroll
                    for (int j = 0; j < 4; ++j) { const f32x4 v = xr[64 * j]; s += (v[0] * v[0] + v[1] * v[1]) + (v[2] * v[2] + v[3] * v[3]); u32x2 w; w.x = cvtpk(v[0], v[1]); w.y = cvtpk(v[2], v[3]); o8[64 * j] = w; }
                    s = wave_sum(s);
                    if (lane < 16) ssA[(size_t)row * 16 + lane] = lane == 0 ? s : 0.f;
                }
            }
        }
        }
}

template <int l> __device__ __forceinline__ void layer_body(const Params& P, LAS unsigned char* lds, unsigned char* lds_raw, cg::grid_group& grid, const int G0, const int bx0, const int vcu0) {
    pg8::StaticOrder SO;
        if (l == 0) { layer_prep<0, 0>(P, lds, G0, bx0, vcu0); GRID_SYNC(); }
#if PH(1)
        REP(2) { PHASE_PTRS pg8::Gemm g{xb2, W1in_t, T, 2 * FF, DM, DM, 0}; SO.init(T, 2 * FF, G, bx); pg8::EpiSwiGLU E{act, ssA};
          pg8::gemm_phase<pg8::EpiSwiGLU, true>(lds, g, SO, E); }
#endif
        if constexpr (l > 0) layer_prep<l, 2>(P, lds, G0, bx0, vcu0);
        GRID_SYNC();
#if PH(2)
#if PROBE == 8
        { PHASE_PTRS const float* xin0 = (l == 0) ? IN(I_X) : xres; pg8::Gemm g{act, W1out_t, T, DM, FF, FF, 0}; SO.init(T, DM, G, bx);
          pg8::EpiResid<false> E{xin0, (float*)(R + 2 * (size_t)T * DM * 2), R + 6 * (size_t)T * DM, agg, nullptr, nullptr, nullptr};
          pg8::gemm_phase<pg8::EpiResid<false>, true>(lds, g, SO, E); }
#endif
        { PHASE_PTRS const float* xin0 = (l == 0) ? IN(I_X) : xres; pg8::Gemm g{act, W1out_t, T, DM, FF, FF, 0}; SO.init(T, DM, G, bx); pg8::EpiResid<false> E{xin0, xres, xb, ssB, nullptr, nullptr, nullptr};
          pg8::gemm_phase<pg8::EpiResid<false>, true>(lds, g, SO, E); }
#endif
        GRID_SYNC();
#if PH(3)
        REP(6) { PHASE_PTRS pg8::Gemm g{xb, Win_t, T, 7 * DM, DM, DM, 0}; SO.init(T, 7 * DM, G, bx); pg8::EpiProj E{R, ssB, IN(I_QN) + l * HD, IN(I_KN) + l * HD, (LAS float*)(lds + 131072)};
          pg8::gemm_phase<pg8::EpiProj, true>(lds, g, SO, E); }
        REP(1) {
            PHASE_PTRS PHASE_IDS_
            LAS float* wl = (LAS float*)lds;
            __syncthreads();
            for (int e = tid; e < DM * 8; e += 512) wl[e] = wfg[e];
            __syncthreads();
            const float* fb = IN(I_FB) + l * NH;
            f32x4 xv[4];
            if (gw < T) { const f32x4* xr0 = (const f32x4*)(xres + (size_t)gw * DM) + lane;
#pragma unroll
                for (int j = 0; j < 4; ++j) xv[j] = xr0[64 * j]; }
            for (int row = gw; row < T; row += NGW) {
                float s = 0.f; float a8[8] = {0.f, 0.f, 0.f, 0.f, 0.f, 0.f, 0.f, 0.f};
                f32x4 xc4[4];
#pragma unroll
                for (int j = 0; j < 4; ++j) xc4[j] = xv[j];
                if (row + NGW < T) { const f32x4* xrn = (const f32x4*)(xres + (size_t)(row + NGW) * DM) + lane;
#pragma unroll
                    for (int j = 0; j < 4; ++j) xv[j] = xrn[64 * j]; }
#pragma unroll
                for (int j = 0; j < 4; ++j) { const f32x4 v = xc4[j]; s += (v[0] * v[0] + v[1] * v[1]) + (v[2] * v[2] + v[3] * v[3]);
#pragma unroll
                    for (int e = 0; e < 4; ++e) { const int k = 256 * j + 4 * lane + e; const f32x4 w0 = *(const LAS f32x4*)(wl + k * 8), w1 = *(const LAS f32x4*)(wl + k * 8 + 4);
                        a8[0] += v[e] * w0[0]; a8[1] += v[e] * w0[1]; a8[2] += v[e] * w0[2]; a8[3] += v[e] * w0[3]; a8[4] += v[e] * w1[0]; a8[5] += v[e] * w1[1]; a8[6] += v[e] * w1[2]; a8[7] += v[e] * w1[3]; } }
                s = wave_sum(s); const float r = rsqrtf(s * (1.f / DM) + EPS);
                float b4[4], c2[2], mine;
                { const bool up = lane & 1;
#pragma unroll
                  for (int i = 0; i < 4; ++i) { const float snd = up ? a8[i] : a8[4 + i], kp = up ? a8[4 + i] : a8[i]; b4[i] = kp + __shfl_xor(snd, 1); } }
                { const bool up = lane & 2;
#pragma unroll
                  for (int i = 0; i < 2; ++i) { const float snd = up ? b4[i] : b4[2 + i], kp = up ? b4[2 + i] : b4[i]; c2[i] = kp + __shfl_xor(snd, 2); } }
                { const bool up = lane & 4; const float snd = up ? c2[0] : c2[1], kp = up ? c2[1] : c2[0]; mine = kp + __shfl_xor(snd, 4); }
                mine += __shfl_xor(mine, 8); mine += __shfl_xor(mine, 16); mine += __shfl_xor(mine, 32);
                if (lane < 8) { const int hh = ((lane & 1) << 2) | (lane & 2) | ((lane >> 2) & 1);
                    const float z = mine * r + fb[hh]; const float lf = (z >= 0.f) ? -log1pf(expf(-z)) : z - log1pf(expf(z));
                    const int b = row / SEQ, t = row % SEQ; logf_[((size_t)(b * NH + hh)) * SEQ + t] = lf; }
            }
        }
#endif
        GRID_SYNC();
#if PH(4)
        {
            PHASE_PTRS PHASE_IDS_
            const float* cw = IN(I_CONVW) + (size_t)l * 4 * DM; const float* cb = IN(I_CONVB) + l * DM;
            REP(1) for (int task = gt; task < (T / 16) * 128; task += NGT) {
                const int cgp = task & 127, run = task >> 7, c0 = cgp * 8, t0 = run * 16;
                float w[4][8], bb[8];
#pragma unroll
                for (int k = 0; k < 4; ++k) { const f32x4 a = *(const f32x4*)(cw + k * DM + c0), b = *(const f32x4*)(cw + k * DM + c0 + 4);
                    w[k][0] = a[0]; w[k][1] = a[1]; w[k][2] = a[2]; w[k][3] = a[3]; w[k][4] = b[0]; w[k][5] = b[1]; w[k][6] = b[2]; w[k][7] = b[3]; }
                { const f32x4 a = *(const f32x4*)(cb + c0), b = *(const f32x4*)(cb + c0 + 4); bb[0] = a[0]; bb[1] = a[1]; bb[2] = a[2]; bb[3] = a[3]; bb[4] = b[0]; bb[5] = b[1]; bb[6] = b[2]; bb[7] = b[3]; }
                float h0[8], h1[8], h2[8];
                const bool first = (t0 % SEQ) == 0;
                u32x4 z = {0u, 0u, 0u, 0u};
                u32x4 r0 = first ? z : *(const u32x4*)(b_rx + (size_t)(t0 - 3) * DM + c0), r1 = first ? z : *(const u32x4*)(b_rx + (size_t)(t0 - 2) * DM + c0), r2 = first ? z : *(const u32x4*)(b_rx + (size_t)(t0 - 1) * DM + c0);
#define UNP(dst, rr) do { dst[0] = bflo(rr.x); dst[1] = bfhi(rr.x); dst[2] = bflo(rr.y); dst[3] = bfhi(rr.y); dst[4] = bflo(rr.z); dst[5] = bfhi(rr.z); dst[6] = bflo(rr.w); dst[7] = bfhi(rr.w); } while (0)
                UNP(h0, r0); UNP(h1, r1); UNP(h2, r2);
#pragma unroll
                for (int i = 0; i < 16; ++i) {
                    const u32x4 rc = *(const u32x4*)(b_rx + (size_t)(t0 + i) * DM + c0); float h3[8]; UNP(h3, rc); float y[8];
#pragma unroll
                    for (int j = 0; j < 8; ++j) { y[j] = bb[j] + w[0][j] * h0[j] + w[1][j] * h1[j] + w[2][j] * h2[j] + w[3][j] * h3[j]; h0[j] = h1[j]; h1[j] = h2[j]; h2[j] = h3[j]; }
                    u32x4 o; o.x = cvtpk(y[0], y[1]); o.y = cvtpk(y[2], y[3]); o.z = cvtpk(y[4], y[5]); o.w = cvtpk(y[6], y[7]);
                    *(u32x4*)(b_rxc + (size_t)(t0 + i) * DM + c0) = o;
                }
            }
#undef UNP
            if (gt == 0) *(unsigned*)(ws + WS_VEC + 262144) = 0u;
            if (vcu < NB * NH) {
                LAS float* wsum = (LAS float*)lds;
                const float* src = logf_ + (size_t)vcu * SEQ + tid * 16; float v[16];
#pragma unroll
                for (int j = 0; j < 4; ++j) { const f32x4 a = *(const f32x4*)(src + 4 * j); v[4 * j] = a[0]; v[4 * j + 1] = a[1]; v[4 * j + 2] = a[2]; v[4 * j + 3] = a[3]; }
#pragma unroll
                for (int j = 1; j < 16; ++j) v[j] += v[j - 1];
                float incl = v[15];
#pragma unroll
                for (int o = 1; o < 64; o <<= 1) { const float n = __shfl_up(incl, o); if (lane >= o) incl += n; }
                __syncthreads();
                if (lane == 63) wsum[wave] = incl;
                __syncthreads();
                float basev = incl - v[15];
                for (int w = 0; w < wave; ++w) basev += wsum[w];
                float* dst = nd2 + (size_t)vcu * SEQ + tid * 16;
#pragma unroll
                for (int j = 0; j < 4; ++j) { f32x4 o; o[0] = -LOG2E * (basev + v[4 * j]); o[1] = -LOG2E * (basev + v[4 * j + 1]); o[2] = -LOG2E * (basev + v[4 * j + 2]); o[3] = -LOG2E * (basev + v[4 * j + 3]); *(f32x4*)(dst + 4 * j) = o; }
                __syncthreads();
            }
        }
#endif
        GRID_SYNC();
#if PH(5)
        REP(5) { PHASE_PTRS pg8::Gemm g{b_rxc, Wg_t, T, 2 * DM, 128, DM, 128}; SO.init(T, 2 * DM, G, bx);
          pg8::EpiGate E{b_rxc, b_L, b_U, IN(I_RGBA) + l * DM, IN(I_RGBX) + l * DM, sp8};
          pg8::gemm_phase<pg8::EpiGate, true>(lds, g, SO, E); }
#endif
#if PH(13)
        { PHASE_PTRS __syncthreads();
        att::attn_phase((char*)lds_raw, (const att::bf16*)b_q, (const att::bf16*)b_k, (const att::bf16*)b_v, (att::bf16*)b_q, nd2, (unsigned*)(ws + WS_VEC + 262144), IN(I_QN) + l * HD, IN(I_KN) + l * HD); }
#endif
        GRID_SYNC();
#if PH(6)
        REP(1) { PHASE_PTRS PHASE_IDS_
        for (int task = gt; task < NB * 64 * 512; task += NGT) {
            const int cp = task & 511, ch = (task >> 9) & 63, b = task >> 15; const size_t base = ((size_t)b * SEQ + (size_t)ch * 128) * DM + cp * 2;
            float A0 = 1.f, A1 = 1.f, H0 = 0.f, H1 = 0.f;
#pragma unroll 16
            for (int i = 0; i < 128; ++i) { const unsigned lw = *(const unsigned*)(b_L + base + (size_t)i * DM), uw = *(const unsigned*)(b_U + base + (size_t)i * DM);
                const float a0 = __builtin_amdgcn_exp2f(bflo(lw) * LOG2E), a1 = __builtin_amdgcn_exp2f(bfhi(lw) * LOG2E);
                A0 *= a0; A1 *= a1; H0 = a0 * H0 + bflo(uw); H1 = a1 * H1 + bfhi(uw); }
            f32x4 o = {A0, H0, A1, H1}; *(f32x4*)(agg + ((size_t)(b * 64 + ch) * DM + cp * 2) * 2) = o;
        } }
#endif
        GRID_SYNC();
#if PH(7)
        REP(1) { PHASE_PTRS PHASE_IDS_
        for (int task = gt; task < NB * 64 * 512; task += NGT) {
            const int cp = task & 511, ch = (task >> 9) & 63, b = task >> 15; const size_t base = ((size_t)b * SEQ + (size_t)ch * 128) * DM + cp * 2;
            float H0 = 0.f, H1 = 0.f;
            for (int j = 0; j < ch; j += 8) {
                f32x4 ag[8];
#pragma unroll
                for (int k = 0; k < 8; ++k) { const int jj = (j + k < ch) ? j + k : j; ag[k] = *(const f32x4*)(agg + ((size_t)(b * 64 + jj) * DM + cp * 2) * 2); }
#pragma unroll
                for (int k = 0; k < 8; ++k) if (j + k < ch) { H0 = ag[k][0] * H0 + ag[k][1]; H1 = ag[k][2] * H1 + ag[k][3]; }
            }
            for (int i0 = 0; i0 < 128; i0 += 16) {
                unsigned lw[16], uw[16], gv[16];
#pragma unroll
                for (int k = 0; k < 16; ++k) { const size_t off = base + (size_t)(i0 + k) * DM; lw[k] = *(const unsigned*)(b_L + off); uw[k] = *(const unsigned*)(b_U + off); gv[k] = *(const unsigned*)(b_rgate + off); }
#pragma unroll
                for (int k = 0; k < 16; ++k) { const size_t off = base + (size_t)(i0 + k) * DM;
                    const float a0 = __builtin_amdgcn_exp2f(bflo(lw[k]) * LOG2E), a1 = __builtin_amdgcn_exp2f(bfhi(lw[k]) * LOG2E);
                    H0 = a0 * H0 + bflo(uw[k]); H1 = a1 * H1 + bfhi(uw[k]);
                    *(unsigned*)(b_ya + off) = cvtpk(H0 * gelu_tanh(bflo(gv[k])), H1 * gelu_tanh(bfhi(gv[k]))); }
            }
        } }
#endif
        GRID_SYNC();
#if PH(8)
        REP(4) {
          { PHASE_PTRS const float* mb = IN(I_MERGEB) + l * 2 * DM; pg8::Gemm g{b_ya, Wr_t, T, DM, DM, DM, 0}; SO.init(T, DM, G, bx); pg8::EpiMerge<false> E{b_ga, mb, nullptr, b_mrg};
            pg8::gemm_phase<pg8::EpiMerge<false>, true>(lds, g, SO, E); }
          { PHASE_PTRS const float* mb = IN(I_MERGEB) + l * 2 * DM; pg8::Gemm g{b_q, Wat_t, T, DM, DM, DM, 0}; SO.init(T, DM, G, bx); pg8::EpiMerge<true> E{b_gb, mb + DM, b_mrg, b_mrg};
            pg8::gemm_phase<pg8::EpiMerge<true>, true>(lds, g, SO, E); } }
#endif
        GRID_SYNC();
#if PH(9)
        { PHASE_PTRS pg8::Gemm g{b_mrg, Wo_t, T, DM, DM, DM, 0}; SO.init(T, DM, G, bx); pg8::EpiResid<false> E{xres, xres, xb, ssA, nullptr, nullptr, nullptr};
          pg8::gemm_phase<pg8::EpiResid<false>, true>(lds, g, SO, E); }
#endif
        GRID_SYNC();
#if PH(10)
        { PHASE_PTRS pg8::Gemm g{xb, W2in_t, T, 2 * FF, DM, DM, 0}; SO.init(T, 2 * FF, G, bx); pg8::EpiSwiGLU E{act, ssA};
          pg8::gemm_phase<pg8::EpiSwiGLU, true>(lds, g, SO, E); }
        { PHASE_PTRS pg8::Gemm g{pb, Wpe_t, T, DM, PLE, PLE, 0}; SO.init(T, DM, G, bx); pg8::EpiPlain E{b_E};
          pg8::gemm_phase<pg8::EpiPlain, true>(lds, g, SO, E); }
#endif
        GRID_SYNC();
#if PH(11)
        { PHASE_PTRS pg8::Gemm g{act, W2out_t, T, DM, FF, FF, 0}; SO.init(T, DM, G, bx); pg8::EpiResid<false> E{xres, xres, xb, ssB, nullptr, nullptr, nullptr};
          pg8::gemm_phase<pg8::EpiResid<false>, true>(lds, g, SO, E); }
#endif
        GRID_SYNC();
#if PH(12)
        { PHASE_PTRS pg8::Gemm g{xb, Wpg_t, T, DM, DM, DM, 0}; SO.init(T, DM, G, bx); pg8::EpiResid<true> E{xres, xres, xb2, ssA, ssB, IN(I_PLEBG) + l * DM, b_E};
          pg8::gemm_phase<pg8::EpiResid<true>, true>(lds, g, SO, E); }
#endif
        if constexpr (l < NL - 1) layer_prep<l + 1, 1>(P, lds, G0, bx0, vcu0);
        GRID_SYNC();
}

__global__ void __launch_bounds__(512, 2) fwd_kernel(Params P) {
    extern __shared__ __attribute__((aligned(16))) unsigned char lds_raw[];
    LAS unsigned char* lds = (LAS unsigned char*)lds_raw;
    cg::grid_group grid = cg::this_grid();
    const int G0 = gridDim.x, bx0 = blockIdx.x;
    const int vcu0 = (G0 % 8 == 0) ? (bx0 % 8) * (G0 / 8) + bx0 / 8 : bx0;
    if (threadIdx.x < 2) ((volatile LAS unsigned*)(lds + LDS_BARST))[threadIdx.x] = 0u;
    if (threadIdx.x == 0) (void)xb_add((unsigned*)(P.ws + WS_BAR) + XB_XCNT(xb_xcc_id()), 1u);
    __syncthreads();
    if (P.ws == nullptr) grid.sync();
    layer_body<0>(P, lds, lds_raw, grid, G0, bx0, vcu0);
    layer_body<1>(P, lds, lds_raw, grid, G0, bx0, vcu0);
    layer_body<2>(P, lds, lds_raw, grid, G0, bx0, vcu0);
    layer_body<3>(P, lds, lds_raw, grid, G0, bx0, vcu0);
    {
        PHASE_PTRS PHASE_IDS_
        const float* gf = IN(I_FINALN);
        f32x4 nv[4];
        if (gw < T) { const f32x4* xr0 = (const f32x4*)(xres + (size_t)gw * DM) + lane;
#pragma unroll
            for (int j = 0; j < 4; ++j) nv[j] = xr0[64 * j]; }
        for (int row = gw; row < T; row += NGW) {
            f32x4* xr = (f32x4*)(xres + (size_t)row * DM) + lane; f32x4 v[4]; float s = 0.f;
#pragma unroll
            for (int j = 0; j < 4; ++j) v[j] = nv[j];
            if (row + NGW < T) { const f32x4* xrn = (const f32x4*)(xres + (size_t)(row + NGW) * DM) + lane;
#pragma unroll
                for (int j = 0; j < 4; ++j) nv[j] = xrn[64 * j]; }
#pragma unroll
            for (int j = 0; j < 4; ++j) { s += (v[j][0] * v[j][0] + v[j][1] * v[j][1]) + (v[j][2] * v[j][2] + v[j][3] * v[j][3]); }
            s = wave_sum(s); const float r = rsqrtf(s * (1.f / DM) + EPS);
#pragma unroll
            for (int j = 0; j < 4; ++j) { const f32x4 gv = *((const f32x4*)gf + lane + 64 * j); xr[64 * j] = v[j] * r * gv; }
        }
    }
}

extern "C" void kernel_launch(void* const* d_in, const int* in_sizes, int n_in, void* d_out, int out_size, void* d_ws, size_t ws_size, hipStream_t stream) {
    static int grid = 0;
    if (grid == 0) {
        if (n_in != 29 || out_size != T * DM || ws_size < WS_END) { fprintf(stderr, "kernel_launch: unexpected problem (n_in %d out %d ws %zu)\n", n_in, out_size, ws_size); grid = -1; return; }
        int dev = 0, cus = 0, per_cu = 0;
        (void)hipGetDevice(&dev); (void)hipDeviceGetAttribute(&cus, hipDeviceAttributeMultiprocessorCount, dev);
        (void)hipFuncSetAttribute((const void*)fwd_kernel, hipFuncAttributeMaxDynamicSharedMemorySize, LDS_BYTES);
        (void)hipOccupancyMaxActiveBlocksPerMultiprocessor(&per_cu, (const void*)fwd_kernel, 512, LDS_BYTES);
        if (cus <= 0) cus = 256;
        grid = cus;
        if (per_cu < 1) fprintf(stderr, "kernel_launch: occupancy query reports %d workgroups per CU\n", per_cu);
        (void)hipGetLastError();
    }
    if (grid < 0) return;
    if (hipMemsetAsync((char*)d_ws + WS_BAR, 0, XCD_BAR_WORDS * 4, stream) != hipSuccess) { fprintf(stderr, "kernel_launch: memset failed\n"); return; }
    Params p{};
    for (int i = 0; i < 29; ++i) p.in[i] = (const float*)d_in[i];
    p.out = (float*)d_out; p.ws = (unsigned char*)d_ws;
    void* args[] = {&p};
    hipError_t e = hipLaunchCooperativeKernel((const void*)fwd_kernel, dim3(grid), dim3(512), args, LDS_BYTES, stream);
    if (e != hipSuccess) fprintf(stderr, "cooperative launch failed: %s (grid %d)\n", hipGetErrorString(e), grid);
}
```
